# Optimizing an MI355X kernel written in HIP

```python
import jax, jax.numpy as jnp
from jax import lax
import numpy as np

D_MODEL = 1024
BATCH = 32
SEQ = 2048
DEPTH = 1
DEC_BATCH = 128
DEC_SEQ = 8
PAST_LEN = 8192
PAGE_SIZE = 128

POOL_WINDOWS = (2, 4, 8, 16)
N_POOL_GROUPS = len(POOL_WINDOWS)
POOL_WIDTH = D_MODEL // 2
POOL_GROUP_DIM = POOL_WIDTH // N_POOL_GROUPS
POOL_STATE = max(POOL_WINDOWS) - 1
ATTN_PATTERNS = ((128, 1), (512, 4), (2048, 16))
N_ATTN_GROUPS = len(ATTN_PATTERNS)
HEAD_DIM = 64
HEADS_PER_GROUP = 4
N_HEADS = N_ATTN_GROUPS * HEADS_PER_GROUP
QKV_WIDTH = N_HEADS * HEAD_DIM
ATTN_OUT_WIDTH = HEADS_PER_GROUP * HEAD_DIM
GATE_WIDTH = D_MODEL
IN_SPLITS = (POOL_WIDTH, POOL_WIDTH + QKV_WIDTH, POOL_WIDTH + 2 * QKV_WIDTH,
             POOL_WIDTH + 3 * QKV_WIDTH, POOL_WIDTH + 3 * QKV_WIDTH + GATE_WIDTH)
IN_WIDTH = POOL_WIDTH + 3 * QKV_WIDTH + 2 * GATE_WIDTH
D_FF = 4 * D_MODEL
QBLOCK = 128
EPS = 1e-6
F32 = jnp.float32

kernel_name = 'gated_pool_dilated_attn_decoder_step'


def rms_norm(x, w):
    x32 = x.astype(F32)
    y = x32 * lax.rsqrt(jnp.mean(jnp.square(x32), axis=-1, keepdims=True) + EPS)
    return y.astype(x.dtype) * w


def project(x, ln1, w_in, q_norm, k_norm):
    B, T, _ = x.shape
    p = jnp.einsum('btd,de->bte', rms_norm(x, ln1), w_in)
    a, q, k, v, g_a, g_b = jnp.split(p, IN_SPLITS, axis=-1)
    heads = lambda t: t.reshape(B, T, N_HEADS, HEAD_DIM)
    return a, rms_norm(heads(q), q_norm), rms_norm(heads(k), k_norm), heads(v), g_a, g_b


def causal_multiscale_pool(a, prev, pos0, lin, scale):
    B, T, _ = a.shape
    P = prev.shape[1]
    full = jnp.concatenate([prev, a], axis=1).astype(F32)
    cs = jnp.concatenate([jnp.zeros((B, 1, POOL_WIDTH), F32), lax.cumsum(full, axis=1)], axis=1)
    end = cs[:, P + 1:]
    pos = pos0 + jnp.arange(T)
    means = []
    for g, w in enumerate(POOL_WINDOWS):
        cg = slice(g * POOL_GROUP_DIM, (g + 1) * POOL_GROUP_DIM)
        start = cs[:, P + 1 - w:P + 1 - w + T, cg]
        cnt = jnp.minimum(pos + 1, w).astype(F32)[None, :, None]
        means.append((end[..., cg] - start) / cnt)
    diff = (jnp.concatenate(means, axis=-1) - a.astype(F32)).astype(a.dtype)
    z = jnp.einsum('btgc,gce->btge', diff.reshape(B, T, N_POOL_GROUPS, POOL_GROUP_DIM), lin)
    return z.reshape(B, T, POOL_WIDTH) * scale


def masked_softmax_stats(s, valid):
    s = jnp.where(valid, s, -jnp.inf)
    m = jnp.max(s, axis=-1, keepdims=True)
    p = jnp.exp(s - m)
    den = jnp.sum(p, axis=-1, keepdims=True)
    return p / den, (m + jnp.log(den))[..., 0]


def dilated_attention_prompt(q, k, v, dil, band):
    B, S, H, Dh = q.shape
    L = S // dil
    nb = -(-L // QBLOCK)
    Lp = nb * QBLOCK
    BD = B * dil

    def by_residue(x):
        x = x.reshape(B, L, dil, H, Dh).transpose(0, 2, 1, 3, 4).reshape(BD, L, H, Dh)
        return jnp.pad(x, ((0, 0), (0, Lp - L), (0, 0), (0, 0))).astype(F32)

    qr, kr, vr = by_residue(q), by_residue(k), by_residue(v)

    def band_rows(x):
        xp = jnp.pad(x, ((0, 0), (QBLOCK, 0), (0, 0), (0, 0)))
        prev = xp[:, :Lp].reshape(BD, nb, QBLOCK, H, Dh)
        cur = x.reshape(BD, nb, QBLOCK, H, Dh)
        return jnp.concatenate([prev, cur], axis=2)

    qb = qr.reshape(BD, nb, QBLOCK, H, Dh)
    kb, vb = band_rows(kr), band_rows(vr)
    s = jnp.einsum('bnqhd,bnkhd->bnhqk', qb, kb) * (HEAD_DIM ** -0.5)
    qi = jnp.arange(QBLOCK)[:, None]
    kj = jnp.arange(2 * QBLOCK)[None, :]
    dist = qi + QBLOCK - kj
    key_pos = jnp.arange(nb)[:, None, None] * QBLOCK - QBLOCK + kj[None]
    valid = (dist >= 0) & (dist <= band) & (key_pos >= 0)
    p, lse = masked_softmax_stats(s, valid[None, :, None])
    o = jnp.einsum('bnhqk,bnkhd->bnqhd', p, vb).reshape(BD, Lp, H, Dh)[:, :L]
    o = o.reshape(B, dil, L, H, Dh).transpose(0, 2, 1, 3, 4).reshape(B, S, H, Dh)
    lse = lse.transpose(0, 1, 3, 2).reshape(BD, Lp, H)[:, :L]
    lse = lse.reshape(B, dil, L, H).transpose(0, 2, 1, 3).reshape(B, S, H)
    return o, lse


def dilated_attention_sample(q, k_full, v_full, dil, band):
    B, T, H, Dh = q.shape
    Lw = k_full.shape[1] - T
    idx = Lw + jnp.arange(T)[:, None] - jnp.arange(band + 1)[None, :] * dil
    valid = idx >= 0
    idxc = jnp.maximum(idx, 0)
    kg = k_full[:, idxc].astype(F32)
    vg = v_full[:, idxc].astype(F32)
    s = jnp.einsum('bthd,btjhd->bthj', q.astype(F32), kg) * (HEAD_DIM ** -0.5)
    p, lse = masked_softmax_stats(s, valid[None, :, None, :])
    return jnp.einsum('bthj,btjhd->bthd', p, vg), lse


def combine_groups(outs, lses, dtype):
    wts = jax.nn.softmax(jnp.stack(lses, axis=0), axis=0)
    o = jnp.einsum('gbth,gbthd->bthd', wts, jnp.stack(outs, axis=0))
    B, T = o.shape[:2]
    return o.reshape(B, T, ATTN_OUT_WIDTH).astype(dtype)


def merge_and_mlp(x, a_mix, attn, g_a, g_b, w_pa, w_pb, w_o, ln2, w_up, w_down):
    branch_a = jnp.einsum('btc,cd->btd', a_mix, w_pa)
    branch_b = jnp.einsum('btc,cd->btd', attn, w_pb)
    mixed = jax.nn.sigmoid(g_a) * branch_a + jax.nn.sigmoid(g_b) * branch_b
    h = x + jnp.einsum('btd,de->bte', mixed, w_o)
    z = jnp.einsum('btd,df->btf', rms_norm(h, ln2), w_up)
    return h + jnp.einsum('btf,fd->btd', jnp.square(jax.nn.relu(z)), w_down)


def setup_inputs(seed: int = 0) -> dict:
    key = jax.random.key(seed)
    ks = jax.random.split(key, 20)
    nrm = lambda k, shape, sc: jax.random.normal(k, shape, F32) * sc
    return {
        'x_prompt': nrm(ks[0], (BATCH, SEQ, D_MODEL), 1.0),
        'x_sample': nrm(ks[1], (DEC_BATCH, DEC_SEQ, D_MODEL), 1.0),
        'state_pool': nrm(ks[2], (DEPTH, DEC_BATCH, POOL_STATE, POOL_WIDTH), 1.0),
        'cache_kv1': nrm(ks[3], (DEPTH, DEC_BATCH, min(ATTN_PATTERNS[0][0], PAST_LEN), 2, HEADS_PER_GROUP, HEAD_DIM), 1.0),
        'cache_kv2': nrm(ks[4], (DEPTH, DEC_BATCH, min(ATTN_PATTERNS[1][0], PAST_LEN), 2, HEADS_PER_GROUP, HEAD_DIM), 1.0),
        'cache_kv3': nrm(ks[5], (DEPTH, DEC_BATCH, min(ATTN_PATTERNS[2][0], PAST_LEN), 2, HEADS_PER_GROUP, HEAD_DIM), 1.0),
        'ln1': 1.0 + nrm(ks[6], (DEPTH, D_MODEL), 0.02),
        'w_in': nrm(ks[7], (DEPTH, D_MODEL, IN_WIDTH), D_MODEL ** -0.5),
        'q_norm': 1.0 + nrm(ks[8], (DEPTH, N_HEADS, HEAD_DIM), 0.02),
        'k_norm': 1.0 + nrm(ks[9], (DEPTH, N_HEADS, HEAD_DIM), 0.02),
        'pool_lin': nrm(ks[10], (DEPTH, N_POOL_GROUPS, POOL_GROUP_DIM, POOL_GROUP_DIM), POOL_GROUP_DIM ** -0.5),
        'pool_scale': 1.0 + nrm(ks[11], (DEPTH, POOL_WIDTH), 0.02),
        'w_pa': nrm(ks[12], (DEPTH, POOL_WIDTH, D_MODEL), POOL_WIDTH ** -0.5),
        'w_pb': nrm(ks[13], (DEPTH, ATTN_OUT_WIDTH, D_MODEL), ATTN_OUT_WIDTH ** -0.5),
        'w_o': nrm(ks[14], (DEPTH, D_MODEL, D_MODEL), D_MODEL ** -0.5),
        'ln2': 1.0 + nrm(ks[15], (DEPTH, D_MODEL), 0.02),
        'w_up': nrm(ks[16], (DEPTH, D_MODEL, D_FF), D_MODEL ** -0.5),
        'w_down': nrm(ks[17], (DEPTH, D_FF, D_MODEL), D_FF ** -0.5),
    }


def reference(x_prompt, x_sample, state_pool, cache_kv1, cache_kv2, cache_kv3, ln1, w_in, q_norm, k_norm,
              pool_lin, pool_scale, w_pa, w_pb, w_o, ln2, w_up, w_down):
    caches = (cache_kv1, cache_kv2, cache_kv3)
    yp, ys = x_prompt, x_sample
    pool_p, pool_s = [], []
    kv_p = [[] for _ in ATTN_PATTERNS]
    kv_s = [[] for _ in ATTN_PATTERNS]
    for l in range(DEPTH):
        a, q, k, v, g_a, g_b = project(yp, ln1[l], w_in[l], q_norm[l], k_norm[l])
        B, S = a.shape[:2]
        a_mix = causal_multiscale_pool(a, jnp.zeros((B, POOL_STATE, POOL_WIDTH), a.dtype), 0,
                                       pool_lin[l], pool_scale[l])
        pool_p.append(a[:, S - POOL_STATE:])
        outs, lses = [], []
        for g, (win, dil) in enumerate(ATTN_PATTERNS):
            hs = slice(g * HEADS_PER_GROUP, (g + 1) * HEADS_PER_GROUP)
            o, lse = dilated_attention_prompt(q[:, :, hs], k[:, :, hs], v[:, :, hs], dil, win // dil)
            outs.append(o)
            lses.append(lse)
            keep = min(win, S)
            kv_p[g].append(jnp.stack([k[:, S - keep:, hs], v[:, S - keep:, hs]], axis=2))
        yp = merge_and_mlp(yp, a_mix, combine_groups(outs, lses, yp.dtype), g_a, g_b,
                           w_pa[l], w_pb[l], w_o[l], ln2[l], w_up[l], w_down[l])

        a, q, k, v, g_a, g_b = project(ys, ln1[l], w_in[l], q_norm[l], k_norm[l])
        T = a.shape[1]
        a_mix = causal_multiscale_pool(a, state_pool[l], PAST_LEN, pool_lin[l], pool_scale[l])
        pool_s.append(jnp.concatenate([state_pool[l], a], axis=1)[:, T:])
        outs, lses = [], []
        for g, (win, dil) in enumerate(ATTN_PATTERNS):
            hs = slice(g * HEADS_PER_GROUP, (g + 1) * HEADS_PER_GROUP)
            buf = caches[g][l]
            k_full = jnp.concatenate([buf[:, :, 0], k[:, :, hs]], axis=1)
            v_full = jnp.concatenate([buf[:, :, 1], v[:, :, hs]], axis=1)
            o, lse = dilated_attention_sample(q[:, :, hs], k_full, v_full, dil, win // dil)
            outs.append(o)
            lses.append(lse)
            kv_s[g].append(jnp.stack([k_full[:, T:], v_full[:, T:]], axis=2))
        ys = merge_and_mlp(ys, a_mix, combine_groups(outs, lses, ys.dtype), g_a, g_b,
                           w_pa[l], w_pb[l], w_o[l], ln2[l], w_up[l], w_down[l])

    pool_prompt = jnp.stack(pool_p)
    kv1_prompt = jnp.stack(kv_p[0])
    kv2_prompt = jnp.stack(kv_p[1])
    kv3_prompt = jnp.stack(kv_p[2])
    pool_sample = jnp.stack(pool_s)
    kv1_sample = jnp.stack(kv_s[0])
    kv2_sample = jnp.stack(kv_s[1])
    kv3_sample = jnp.stack(kv_s[2])
    return (yp, ys, pool_prompt, kv1_prompt, kv2_prompt, kv3_prompt, pool_sample, kv1_sample, kv2_sample, kv3_sample)
```

```cpp
#include <hip/hip_runtime.h>
#include <hip/hip_cooperative_groups.h>
#include <cstdio>
#include <cstdint>
namespace cg = cooperative_groups;
namespace pg8 {
#define PG8_LAS __attribute__((address_space(3)))
typedef unsigned short bf16_t;
typedef short bf16x8 __attribute__((ext_vector_type(8)));
typedef float f32x4 __attribute__((ext_vector_type(4)));
typedef unsigned u32x4 __attribute__((ext_vector_type(4)));
constexpr int BM = 256, BK = 64, HALF = 128, HTB = HALF * BK * 2  , STAGE_BYTES = 8 * HTB, NXCD = 8, WGM = 8;

__host__ __device__ __forceinline__ int lds_byte(int r, int c) { const int st = (r >> 4) * 2 + (c >> 5), rr = r & 15, cc = c & 31, ob = rr * 64 + cc * 2; return st * 1024 + (ob ^ (((ob >> 9) & 1) << 5)); }
__host__ __device__ __forceinline__ void stage_rc(int b, int& R, int& C) { const int st = b / 1024, sb = b % 1024, swz = sb ^ (((sb >> 9) & 1) << 5); R = (st >> 1) * 16 + swz / 64; C = (st & 1) * 32 + (swz % 64) / 2; }
__host__ __device__ __forceinline__ int perm32(int rho) { const int n = rho >> 4, i = rho & 15; return 8 * (i >> 2) + 4 * n + (i & 3); }

struct Unit { int pm, pn; };
struct Gemm { const bf16_t* A; const bf16_t* Bt; int M, N, K; };

struct StaticOrder {
    int nM, nN, nwg, G, c;
    __host__ __device__ void init(int M, int N, int G_, int c_) { nM = M / BM; nN = N / BM; nwg = nM * nN; G = G_; c = c_; }
    __host__ __device__ bool next(int i, Unit& u) const {
        const long L = (long)i * G + c; if (L >= nwg) return false;
        int wgid = (int)L; { const int q = nwg / NXCD, r = nwg % NXCD, xcd = wgid % NXCD, off = wgid / NXCD; wgid = (xcd < r ? xcd * (q + 1) : r * (q + 1) + (xcd - r) * q) + off; }
        const int nig = WGM * nN, gid = wgid / nig, fm = gid * WGM, gsz = (nM - fm) < WGM ? (nM - fm) : WGM;
        u.pm = fm + ((wgid % nig) % gsz); u.pn = (wgid % nig) / gsz; return true;
    }
    __device__ __forceinline__ void a_ready(const Unit&) const {}
    __device__ __forceinline__ void done(const Unit&) const {}
};

__device__ __forceinline__ unsigned cvt_pk_bf16(float lo, float hi) { unsigned r; asm volatile("v_cvt_pk_bf16_f32 %0, %1, %2" : "=v"(r) : "v"(lo), "v"(hi)); return r; }
typedef float f32x2 __attribute__((ext_vector_type(2)));
template <class Epi, class Sched, bool ALIGN_EPI = false, bool SP2 = false>
__device__ __forceinline__ void gemm_phase(PG8_LAS unsigned char* lds, const Gemm g, const Sched& S, const Epi& E) {
    int tid_ = threadIdx.x; asm volatile("" : "+v"(tid_));
    const int tid = tid_, wid = __builtin_amdgcn_readfirstlane(tid >> 6), lane = tid & 63, wr = wid >> 2, wc = wid & 3, fr = lane & 15, fq = lane >> 4;
    const int K = g.K, nt = K / BK;
    unsigned voffA[2], voffB[2];
#pragma unroll
    for (int i = 0; i < 2; ++i) { int R, C; stage_rc(tid * 16 + i * 8192, R, C); const int Rb = Epi::PERM ? ((R & ~31) + perm32(R & 31)) : R;
        voffA[i] = (unsigned)(R * K + C) * 2u; voffB[i] = (unsigned)(Rb * K + C) * 2u; }
    const size_t kstep = (size_t)(BK * 2);
    const size_t hstep = (size_t)HALF * K * 2;
    const size_t tstep = 2 * hstep;
    const unsigned ldsw = (unsigned)wid * 1024u;
    const int aoff = lds_byte(wr * 64 + fr, fq * 8), boff = lds_byte(wc * 32 + fr, fq * 8);
#define PG8_SA(b, h) (((b) * 2 + (h)) * HTB)
#define PG8_SB(b, h) ((4 + (b) * 2 + (h)) * HTB)
#define PG8_STAGE(bufoff, gbase, voff) do { _Pragma("unroll") for (int _i = 0; _i < 2; ++_i) \
        __builtin_amdgcn_global_load_lds((const unsigned*)((const char*)(gbase) + (voff)[_i]), (PG8_LAS unsigned*)(lds + (bufoff) + ldsw + _i * 8192), 16, 0, 0); } while (0)
#define PG8_LDA(dst, b, h) do { _Pragma("unroll") for (int m = 0; m < 4; ++m) _Pragma("unroll") for (int k = 0; k < 2; ++k) dst[m][k] = *(const PG8_LAS bf16x8*)(lds + PG8_SA(b, h) + aoff + m * 2048 + k * 1024); } while (0)
#define PG8_LDB(dst, b, h) do { _Pragma("unroll") for (int n = 0; n < 2; ++n) _Pragma("unroll") for (int k = 0; k < 2; ++k) dst[n][k] = *(const PG8_LAS bf16x8*)(lds + PG8_SB(b, h) + boff + n * 2048 + k * 1024); } while (0)
#define PG8_MMA(ai, bj, At, Bt) do { __builtin_amdgcn_s_setprio(1); _Pragma("unroll") for (int m = 0; m < 4; ++m) _Pragma("unroll") for (int n = 0; n < 2; ++n) _Pragma("unroll") for (int k = 0; k < 2; ++k) \
        acc[ai][bj][m][n] = __builtin_amdgcn_mfma_f32_16x16x32_bf16(Bt[n][k], At[m][k], acc[ai][bj][m][n], 0, 0, 0); __builtin_amdgcn_s_setprio(0); } while (0)
#define PG8_WAIT_V(n) asm volatile("s_waitcnt vmcnt(" #n ")" ::: "memory")
#define PG8_WAIT_L(n) asm volatile("s_waitcnt lgkmcnt(" #n ")" ::: "memory")
#define PG8_BAR __builtin_amdgcn_s_barrier()
#define PG8_SCHED __builtin_amdgcn_sched_barrier(0)
    Unit cur, nxt; int ui = 0;
    if (!S.next(0, cur)) return;
    f32x4 acc[2][2][4][2];
#pragma unroll
    for (int a = 0; a < 2; ++a)
#pragma unroll
        for (int b = 0; b < 2; ++b)
#pragma unroll
            for (int m = 0; m < 4; ++m)
#pragma unroll
                for (int n = 0; n < 2; ++n) acc[a][b][m][n] = (f32x4){0.f, 0.f, 0.f, 0.f};
    bf16x8 At[4][2], B0[2][2], B1[2][2];
    const char* cA = (const char*)g.A + (size_t)cur.pm * tstep; const char* cB = (const char*)g.Bt + (size_t)cur.pn * tstep;
    S.a_ready(cur);
    if constexpr (SP2) {
        PG8_STAGE(PG8_SB(0, 0), cB, voffB); PG8_STAGE(PG8_SB(0, 1), cB + hstep, voffB); PG8_STAGE(PG8_SA(0, 0), cA, voffA); PG8_STAGE(PG8_SA(0, 1), cA + hstep, voffA);
        if (wr == 1) PG8_BAR;
        PG8_WAIT_V(2); PG8_BAR;
        PG8_STAGE(PG8_SB(1, 0), cB + kstep, voffB); PG8_STAGE(PG8_SA(1, 0), cA + kstep, voffA); PG8_STAGE(PG8_SB(1, 1), cB + hstep + kstep, voffB);
        PG8_WAIT_V(6); PG8_BAR;
    } else {
        PG8_STAGE(PG8_SB(0, 0), cB, voffB); PG8_STAGE(PG8_SA(0, 0), cA, voffA); PG8_STAGE(PG8_SB(0, 1), cB + hstep, voffB); PG8_STAGE(PG8_SA(0, 1), cA + hstep, voffA);
        if (wr == 1) PG8_BAR;
        PG8_WAIT_V(4); PG8_BAR;
        PG8_STAGE(PG8_SB(1, 0), cB + kstep, voffB); PG8_STAGE(PG8_SA(1, 0), cA + kstep, voffA); PG8_STAGE(PG8_SB(1, 1), cB + hstep + kstep, voffB);
        PG8_WAIT_V(6); PG8_BAR;
    }
    for (;;) {
        const bool has_next = S.next(ui + 1, nxt);
        const char* nA = has_next ? (const char*)g.A + (size_t)nxt.pm * tstep : cA; const char* nB = has_next ? (const char*)g.Bt + (size_t)nxt.pn * tstep : cB;
        for (int t = 0; t < nt; t += 2) {
            const bool last = (t == nt - 2);
            const char* a1 = cA + (size_t)(t + 1) * kstep;
            const char* a2 = last ? nA : cA + (size_t)(t + 2) * kstep; const char* b2 = last ? nB : cB + (size_t)(t + 2) * kstep;
            const char* a3 = a2 + kstep; const char* b3 = b2 + kstep;
            if (last && has_next) S.a_ready(nxt);
            if constexpr (SP2) {
            PG8_LDB(B0, 0, 0); PG8_LDB(B1, 0, 1); PG8_SCHED; PG8_LDA(At, 0, 0); PG8_STAGE(PG8_SA(1, 1), a1 + hstep, voffA);
            PG8_WAIT_V(8); PG8_WAIT_L(0); PG8_BAR; PG8_MMA(0, 0, At, B0); PG8_MMA(0, 1, At, B1); PG8_BAR; PG8_SCHED;
            PG8_LDA(At, 0, 1); PG8_STAGE(PG8_SB(0, 0), b2, voffB); PG8_STAGE(PG8_SB(0, 1), b2 + hstep, voffB); PG8_STAGE(PG8_SA(0, 0), a2, voffA);
            PG8_WAIT_V(8); PG8_WAIT_L(0); PG8_BAR; PG8_MMA(1, 0, At, B0); PG8_MMA(1, 1, At, B1); PG8_BAR; PG8_SCHED;
            PG8_LDB(B0, 1, 0); PG8_LDB(B1, 1, 1); PG8_SCHED; PG8_LDA(At, 1, 0); PG8_STAGE(PG8_SA(0, 1), a2 + hstep, voffA);
            PG8_WAIT_V(8); PG8_WAIT_L(0); PG8_BAR; PG8_MMA(0, 0, At, B0); PG8_MMA(0, 1, At, B1); PG8_BAR; PG8_SCHED;
            PG8_LDA(At, 1, 1); PG8_STAGE(PG8_SB(1, 0), b3, voffB); PG8_STAGE(PG8_SB(1, 1), b3 + hstep, voffB); PG8_STAGE(PG8_SA(1, 0), a3, voffA);
            PG8_WAIT_V(8); PG8_WAIT_L(0); PG8_BAR; PG8_MMA(1, 0, At, B0); PG8_MMA(1, 1, At, B1); PG8_BAR; PG8_SCHED;
            } else {
            PG8_LDB(B0, 0, 0); PG8_SCHED; PG8_LDA(At, 0, 0); PG8_STAGE(PG8_SA(1, 1), a1 + hstep, voffA);
            PG8_WAIT_L(8); PG8_BAR; PG8_WAIT_L(0); PG8_MMA(0, 0, At, B0); PG8_BAR; PG8_SCHED;
            PG8_LDB(B1, 0, 1); PG8_STAGE(PG8_SB(0, 0), b2, voffB);
            PG8_BAR; PG8_WAIT_L(0); PG8_MMA(0, 1, At, B1); PG8_BAR;
            PG8_LDA(At, 0, 1); PG8_STAGE(PG8_SA(0, 0), a2, voffA);
            PG8_BAR; PG8_WAIT_L(0); PG8_MMA(1, 0, At, B0); PG8_BAR; PG8_SCHED;
            PG8_STAGE(PG8_SB(0, 1), b2 + hstep, voffB);
            PG8_WAIT_V(6); PG8_BAR; PG8_MMA(1, 1, At, B1); PG8_BAR;
            PG8_LDB(B0, 1, 0); PG8_SCHED; PG8_LDA(At, 1, 0); PG8_STAGE(PG8_SA(0, 1), a2 + hstep, voffA);
            PG8_WAIT_L(8); PG8_BAR; PG8_WAIT_L(0); PG8_MMA(0, 0, At, B0); PG8_BAR; PG8_SCHED;
            PG8_LDB(B1, 1, 1); PG8_STAGE(PG8_SB(1, 0), b3, voffB);
            PG8_BAR; PG8_WAIT_L(0); PG8_MMA(0, 1, At, B1); PG8_BAR;
            PG8_LDA(At, 1, 1); PG8_STAGE(PG8_SA(1, 0), a3, voffA);
            PG8_BAR; PG8_WAIT_L(0); PG8_MMA(1, 0, At, B0); PG8_BAR; PG8_SCHED;
            PG8_STAGE(PG8_SB(1, 1), b3 + hstep, voffB);
            PG8_WAIT_V(6); PG8_BAR; PG8_MMA(1, 1, At, B1); PG8_BAR;
            }
        }
        if constexpr (ALIGN_EPI) { if (wr == 0) PG8_BAR; }
        if constexpr (!Epi::AFTER_DRAIN) { E(acc, cur, wr, wc, fr, fq); S.done(cur); }
        if (!has_next) break;
#pragma unroll
        for (int a = 0; a < 2; ++a)
#pragma unroll
            for (int b = 0; b < 2; ++b)
#pragma unroll
                for (int m = 0; m < 4; ++m)
#pragma unroll
                    for (int n = 0; n < 2; ++n) acc[a][b][m][n] = (f32x4){0.f, 0.f, 0.f, 0.f};
        cur = nxt; cA = nA; cB = nB; ++ui;
        if constexpr (ALIGN_EPI) { if (wr == 1) PG8_BAR; }
    }
    PG8_WAIT_V(0);
    if constexpr (!ALIGN_EPI) { if (wr == 0) PG8_BAR; }
    PG8_BAR;
    if constexpr (Epi::AFTER_DRAIN) { E.fused(acc, cur, wr, wc, fr, fq, lds, wid, lane); S.done(cur); }
#undef PG8_SA
#undef PG8_SB
#undef PG8_STAGE
#undef PG8_LDA
#undef PG8_LDB
#undef PG8_MMA
#undef PG8_WAIT_V
#undef PG8_WAIT_L
#undef PG8_BAR
#undef PG8_SCHED
}
}
namespace mk {
using pg8::bf16_t; using pg8::f32x4; using pg8::u32x4; using pg8::bf16x8; using pg8::Unit; using pg8::cvt_pk_bf16;
typedef unsigned u32x2 __attribute__((ext_vector_type(2)));
#define LAS __attribute__((address_space(3)))
constexpr int D = 1024, SEQ = 2048, NB = 32, MP = NB * SEQ, SB = 128, ST = 8, MS = SB * ST, M = MP + MS;
constexpr int NIN = 4864, FF = 4096, PW = 512;
constexpr float EPS = 1e-6f;
constexpr float QSCALE = 0.125f * 1.4426950408889634f;
constexpr size_t O_Y = 0, O_POOLP = (size_t)M * D, O_KVP0 = O_POOLP + (size_t)NB * 15 * 512, O_KVP1 = O_KVP0 + (size_t)NB * 128 * 512, O_KVP2 = O_KVP1 + (size_t)NB * 512 * 512,
                 O_POOLS = O_KVP2 + (size_t)NB * 2048 * 512, O_KVS0 = O_POOLS + (size_t)SB * 15 * 512, O_KVS1 = O_KVS0 + (size_t)SB * 128 * 512, O_KVS2 = O_KVS1 + (size_t)SB * 512 * 512,
                 O_END = O_KVS2 + (size_t)SB * 2048 * 512;
__host__ __device__ __forceinline__ constexpr size_t o_kvp(int g) { return g == 0 ? O_KVP0 : (g == 1 ? O_KVP1 : O_KVP2); }
__host__ __device__ __forceinline__ constexpr size_t o_kvs(int g) { return g == 0 ? O_KVS0 : (g == 1 ? O_KVS1 : O_KVS2); }
constexpr size_t al1m(size_t x) { return (x + 1048575) & ~(size_t)1048575; }
constexpr size_t WS_WIN = 1048576, WS_WEFF = al1m(WS_WIN + (size_t)NIN * D * 2), WS_WPB = al1m(WS_WEFF + (size_t)D * 512 * 2), WS_WO = al1m(WS_WPB + (size_t)D * 256 * 2),
                 WS_WUP = al1m(WS_WO + (size_t)D * D * 2), WS_WDN = al1m(WS_WUP + (size_t)FF * D * 2), WS_SSP = al1m(WS_WDN + (size_t)FF * D * 2), WS_LSE = al1m(WS_SSP + (size_t)M * 16 * 4),
                 WS_DIFF = al1m(WS_LSE + (size_t)3 * MP * 4 * 4), WS_OG = al1m(WS_DIFF + (size_t)M * 512 * 2), WS_ATTN = al1m(WS_OG + (size_t)3 * MP * 256 * 2),
                 WS_MIX = al1m(WS_ATTN + (size_t)M * 256 * 2), WS_HN = al1m(WS_MIX + (size_t)M * D * 2), WS_BIG = al1m(WS_HN + (size_t)M * D * 2),
                 WS_U = WS_BIG, WS_A = al1m(WS_U + (size_t)M * D * 2), WS_QG = al1m(WS_A + (size_t)M * 512 * 2), WS_KG = al1m(WS_QG + (size_t)3 * M * 256 * 2),
                 WS_VT = al1m(WS_KG + (size_t)3 * MP * 256 * 2), WS_GA = al1m(WS_VT + (size_t)3 * 8192 * 2048 * 2), WS_GB = al1m(WS_GA + (size_t)M * D * 2), WS_BIGEND = al1m(WS_GB + (size_t)M * D * 2),
                 WS_Z = WS_BIG, WS_END = (WS_Z + (size_t)M * FF * 2 > WS_BIGEND) ? al1m(WS_Z + (size_t)M * FF * 2) : WS_BIGEND;

struct Params {
    const float *xp, *xs, *state_pool, *cache0, *cache1, *cache2, *ln1, *w_in, *q_norm, *k_norm, *pool_lin, *pool_scale, *w_pa, *w_pb, *w_o, *ln2, *w_up, *w_down;
    float* out; unsigned char* ws;
};

__device__ __forceinline__ unsigned f2bf(float f) { unsigned u = __builtin_bit_cast(unsigned, f); return (u + 0x7fffu + ((u >> 16) & 1u)) >> 16; }
__device__ __forceinline__ unsigned pk2(float lo, float hi) { return f2bf(lo) | (f2bf(hi) << 16); }
__device__ __forceinline__ float bflo(unsigned w) { return __builtin_bit_cast(float, w << 16); }
__device__ __forceinline__ float bfhi(unsigned w) { return __builtin_bit_cast(float, w & 0xffff0000u); }
__device__ __forceinline__ u32x4 pack8(const f32x4 a, const f32x4 b) { u32x4 w; w.x = cvt_pk_bf16(a[0], a[1]); w.y = cvt_pk_bf16(a[2], a[3]); w.z = cvt_pk_bf16(b[0], b[1]); w.w = cvt_pk_bf16(b[2], b[3]); return w; }
__device__ __forceinline__ void unpack8(const u32x4 w, f32x4& a, f32x4& b) { a = (f32x4){bflo(w.x), bfhi(w.x), bflo(w.y), bfhi(w.y)}; b = (f32x4){bflo(w.z), bfhi(w.z), bflo(w.w), bfhi(w.w)}; }
__device__ __forceinline__ float dot4(const f32x4 a, const f32x4 b) { return (a[0] * b[0] + a[1] * b[1]) + (a[2] * b[2] + a[3] * b[3]); }
__device__ __forceinline__ float wave_sum(float v) {
#pragma unroll
    for (int o = 1; o < 64; o <<= 1) v += __shfl_xor(v, o);
    return v;
}

struct EpiIn {
    static constexpr bool PERM = true, AFTER_DRAIN = false;
    bf16_t *A, *QG, *KG, *VT, *GA, *GB; float* out; const float *qn, *kn;
    __device__ __forceinline__ void operator()(const f32x4 (&acc)[2][2][4][2], const Unit& u, int wr, int wc, int fr, int fq) const {
        const int pn = u.pn; const bool sample = u.pm >= 256;
        const int rbase = u.pm * 256 + wr * 64 + fr;
        if (pn < 2) {
#pragma unroll
            for (int ai = 0; ai < 2; ++ai)
#pragma unroll
                for (int m = 0; m < 4; ++m) { const int row = rbase + ai * 128 + m * 16;
#pragma unroll
                    for (int bj = 0; bj < 2; ++bj) { const int col = pn * 256 + bj * 128 + wc * 32 + fq * 8; const f32x4 v0 = acc[ai][bj][m][0], v1 = acc[ai][bj][m][1];
                        *(u32x4*)(A + (size_t)row * 512 + col) = pack8(v0, v1);
                        if (!sample) { const int b = row >> 11, t = row & 2047; if (t >= 2033) { float* p = out + O_POOLP + (size_t)(b * 15 + t - 2033) * 512 + col; *(f32x4*)p = v0; *(f32x4*)(p + 4) = v1; } }
                        else { const int sr = row - MP, b = sr >> 3, t = sr & 7; float* p = out + O_POOLS + (size_t)(b * 15 + 7 + t) * 512 + col; *(f32x4*)p = v0; *(f32x4*)(p + 4) = v1; } } }
        } else if (pn < 8) {
            const bool isq = pn < 5; const int g = isq ? pn - 2 : pn - 5; const int sh = 2 * g, dil = 1 << sh, L = 2048 >> sh, keep = 128 << sh;
            const float* nw = (isq ? qn : kn) + (g * 4 + wc) * 64 + fq * 8;
            f32x4 w[2][2];
#pragma unroll
            for (int bj = 0; bj < 2; ++bj) { w[bj][0] = *(const f32x4*)(nw + bj * 32); w[bj][1] = *(const f32x4*)(nw + bj * 32 + 4); }
            const size_t okp = g == 0 ? O_KVP0 : (g == 1 ? O_KVP1 : O_KVP2), oks = g == 0 ? O_KVS0 : (g == 1 ? O_KVS1 : O_KVS2);
#pragma unroll
            for (int ai = 0; ai < 2; ++ai)
#pragma unroll
                for (int m = 0; m < 4; ++m) { const int row = rbase + ai * 128 + m * 16;
                    float ss = 0.f;
#pragma unroll
                    for (int bj = 0; bj < 2; ++bj)
#pragma unroll
                        for (int n = 0; n < 2; ++n) ss += dot4(acc[ai][bj][m][n], acc[ai][bj][m][n]);
                    ss += __shfl_xor(ss, 16); ss += __shfl_xor(ss, 32);
                    float rs = __builtin_amdgcn_rsqf(ss * (1.0f / 64.0f) + EPS); if (isq) rs *= QSCALE;
                    int b, t, Rg;
                    if (!sample) { b = row >> 11; t = row & 2047; Rg = b * 524288 + (t & (dil - 1)) * (L * 256) + (t >> sh) * 64 + wc * (L * 64); } else { const int sr = row - MP; b = sr >> 3; t = sr & 7; Rg = row * 256 + wc * 64; }
#pragma unroll
                    for (int bj = 0; bj < 2; ++bj) { const int hc = wc * 64 + bj * 32 + fq * 8, dd = bj * 32 + fq * 8;
                        const f32x4 v0 = acc[ai][bj][m][0] * rs * w[bj][0], v1 = acc[ai][bj][m][1] * rs * w[bj][1];
                        if (isq) { *(u32x4*)(QG + (size_t)g * M * 256 + (size_t)Rg + dd) = pack8(v0, v1); }
                        else {
                            if (!sample) { *(u32x4*)(KG + (size_t)g * MP * 256 + (size_t)Rg + dd) = pack8(v0, v1);
                                if (t >= 2048 - keep) { float* p = out + okp + ((size_t)(b * keep + t - (2048 - keep)) * 2) * 256 + hc; *(f32x4*)p = v0; *(f32x4*)(p + 4) = v1; } }
                            else { float* p = out + oks + ((size_t)(b * keep + keep - 8 + t) * 2) * 256 + hc; *(f32x4*)p = v0; *(f32x4*)(p + 4) = v1; } } } }
        } else if (pn < 11) {
            const int g = pn - 8; const int sh = 2 * g, dil = 1 << sh, L = 2048 >> sh, keep = 128 << sh;
            const size_t okp = g == 0 ? O_KVP0 : (g == 1 ? O_KVP1 : O_KVP2), oks = g == 0 ? O_KVS0 : (g == 1 ? O_KVS1 : O_KVS2);
#pragma unroll
            for (int ai = 0; ai < 2; ++ai)
#pragma unroll
                for (int m = 0; m < 4; ++m) { const int row = rbase + ai * 128 + m * 16;
                    int b, t;
                    if (!sample) { b = row >> 11; t = row & 2047; } else { const int sr = row - MP; b = sr >> 3; t = sr & 7; }
#pragma unroll
                    for (int bj = 0; bj < 2; ++bj) { const int hc = bj * 128 + wc * 32 + fq * 8; const f32x4 v0 = acc[ai][bj][m][0], v1 = acc[ai][bj][m][1];
                        if (!sample) {
                            *(u32x4*)(VT + (size_t)g * MP * 256 + (size_t)b * 524288 + (t & (dil - 1)) * (L * 256) + (hc >> 6) * (L * 64) + (t >> sh) * 64 + (hc & 63)) = pack8(v0, v1);
                            if (t >= 2048 - keep) { float* p = out + okp + ((size_t)(b * keep + t - (2048 - keep)) * 2 + 1) * 256 + hc; *(f32x4*)p = v0; *(f32x4*)(p + 4) = v1; } }
                        else { float* p = out + oks + ((size_t)(b * keep + keep - 8 + t) * 2 + 1) * 256 + hc; *(f32x4*)p = v0; *(f32x4*)(p + 4) = v1; } } }
        } else {
            bf16_t* G = pn < 15 ? GA : GB; const int cb = (pn < 15 ? pn - 11 : pn - 15) * 256 + wc * 32 + fq * 8;
#pragma unroll
            for (int ai = 0; ai < 2; ++ai)
#pragma unroll
                for (int m = 0; m < 4; ++m) { const int row = rbase + ai * 128 + m * 16;
#pragma unroll
                    for (int bj = 0; bj < 2; ++bj) { f32x4 v0 = acc[ai][bj][m][0], v1 = acc[ai][bj][m][1];
#pragma unroll
                        for (int i = 0; i < 4; ++i) { v0[i] = __builtin_amdgcn_rcpf(1.0f + __expf(-v0[i])); v1[i] = __builtin_amdgcn_rcpf(1.0f + __expf(-v1[i])); }
                        *(u32x4*)(G + (size_t)row * 1024 + cb + bj * 128) = pack8(v0, v1); } }
        }
    }
};
template <bool FIRST> struct EpiGate {
    static constexpr bool PERM = true, AFTER_DRAIN = false;
    const bf16_t* G; bf16_t* O;
    __device__ __forceinline__ void operator()(const f32x4 (&acc)[2][2][4][2], const Unit& u, int wr, int wc, int fr, int fq) const {
        const int rbase = u.pm * 256 + wr * 64 + fr, cb = u.pn * 256 + wc * 32 + fq * 8;
#pragma unroll
        for (int ai = 0; ai < 2; ++ai)
#pragma unroll
            for (int m = 0; m < 4; ++m) { const size_t ro = (size_t)(rbase + ai * 128 + m * 16) * 1024 + cb;
#pragma unroll
                for (int bj = 0; bj < 2; ++bj) { f32x4 g0, g1; unpack8(*(const u32x4*)(G + ro + bj * 128), g0, g1);
                    f32x4 v0 = acc[ai][bj][m][0] * g0, v1 = acc[ai][bj][m][1] * g1;
                    if (!FIRST) { f32x4 o0, o1; unpack8(*(const u32x4*)(O + ro + bj * 128), o0, o1); v0 += o0; v1 += o1; }
                    *(u32x4*)(O + ro + bj * 128) = pack8(v0, v1); }
                asm volatile("" ::: "memory"); }
    }
};
struct EpiH {
    static constexpr bool PERM = true, AFTER_DRAIN = false;
    const float *xp, *xs, *ln2; float* y; bf16_t* HN; float* SSP;
    __device__ __forceinline__ void operator()(const f32x4 (&acc)[2][2][4][2], const Unit& u, int wr, int wc, int fr, int fq) const {
        const int rbase = u.pm * 256 + wr * 64 + fr, cb = u.pn * 256 + wc * 32 + fq * 8;
        f32x4 w[2][2];
#pragma unroll
        for (int bj = 0; bj < 2; ++bj) { w[bj][0] = *(const f32x4*)(ln2 + cb + bj * 128); w[bj][1] = *(const f32x4*)(ln2 + cb + bj * 128 + 4); }
#pragma unroll
        for (int ai = 0; ai < 2; ++ai)
#pragma unroll
            for (int m = 0; m < 4; ++m) { const int row = rbase + ai * 128 + m * 16; const float* xr = (row < MP ? xp + (size_t)row * 1024 : xs + (size_t)(row - MP) * 1024) + cb;
                float ss = 0.f;
#pragma unroll
                for (int bj = 0; bj < 2; ++bj) { const f32x4 h0 = *(const f32x4*)(xr + bj * 128) + acc[ai][bj][m][0], h1 = *(const f32x4*)(xr + bj * 128 + 4) + acc[ai][bj][m][1];
                    float* yp = y + (size_t)row * 1024 + cb + bj * 128; *(f32x4*)yp = h0; *(f32x4*)(yp + 4) = h1;
                    ss += dot4(h0, h0) + dot4(h1, h1);
                    *(u32x4*)(HN + (size_t)row * 1024 + cb + bj * 128) = pack8(h0 * w[bj][0], h1 * w[bj][1]); }
                ss += __shfl_xor(ss, 16); ss += __shfl_xor(ss, 32);
                if (fq == 0) SSP[(size_t)row * 16 + u.pn * 4 + wc] = ss;
                asm volatile("" ::: "memory"); }
    }
};
struct EpiUp {
    static constexpr bool PERM = true, AFTER_DRAIN = false;
    const float* SSP; bf16_t* Z;
    __device__ __forceinline__ void operator()(const f32x4 (&acc)[2][2][4][2], const Unit& u, int wr, int wc, int fr, int fq) const {
        const int rbase = u.pm * 256 + wr * 64 + fr, cb = u.pn * 256 + wc * 32 + fq * 8;
#pragma unroll
        for (int ai = 0; ai < 2; ++ai)
#pragma unroll
            for (int m = 0; m < 4; ++m) { const int row = rbase + ai * 128 + m * 16; const f32x4* sp = (const f32x4*)(SSP + (size_t)row * 16);
                const f32x4 s4 = (sp[0] + sp[1]) + (sp[2] + sp[3]); const float rstd = __builtin_amdgcn_rsqf(((s4[0] + s4[1]) + (s4[2] + s4[3])) * (1.0f / 1024.0f) + EPS);
#pragma unroll
                for (int bj = 0; bj < 2; ++bj) { f32x4 v0 = acc[ai][bj][m][0] * rstd, v1 = acc[ai][bj][m][1] * rstd;
#pragma unroll
                    for (int i = 0; i < 4; ++i) { const float a = fmaxf(v0[i], 0.f), b = fmaxf(v1[i], 0.f); v0[i] = a * a; v1[i] = b * b; }
                    *(u32x4*)(Z + (size_t)row * FF + cb + bj * 128) = pack8(v0, v1); }
                asm volatile("" ::: "memory"); }
    }
};
struct EpiDown {
    static constexpr bool PERM = true, AFTER_DRAIN = false;
    float* y;
    __device__ __forceinline__ void operator()(const f32x4 (&acc)[2][2][4][2], const Unit& u, int wr, int wc, int fr, int fq) const {
        const int rbase = u.pm * 256 + wr * 64 + fr, cb = u.pn * 256 + wc * 32 + fq * 8;
#pragma unroll
        for (int ai = 0; ai < 2; ++ai)
#pragma unroll
            for (int m = 0; m < 4; ++m) { float* yr = y + (size_t)(rbase + ai * 128 + m * 16) * 1024 + cb;
#pragma unroll
                for (int bj = 0; bj < 2; ++bj) { float* yp = yr + bj * 128; const f32x4 a = *(const f32x4*)yp + acc[ai][bj][m][0], b = *(const f32x4*)(yp + 4) + acc[ai][bj][m][1]; *(f32x4*)yp = a; *(f32x4*)(yp + 4) = b; }
                asm volatile("" ::: "memory"); }
    }
};
template <bool PERMQK> __device__ __forceinline__ void p0_transpose_item(const float* W, int K, int N, bf16_t* WT, LAS float* scr, int item, int lane) {
    const int nblk = N / 32, kb = item / nblk, nb = item % nblk, k0 = 64 * kb, n0 = 32 * nb;
    int pn0 = n0;
    if (PERMQK) { if (n0 >= 512 && n0 < 2048) { const int tile = n0 >> 8, blk = (n0 >> 5) & 7, wc = blk >> 1, bj = blk & 1; pn0 = tile * 256 + bj * 128 + wc * 32; } }
#pragma unroll
    for (int i = 0; i < 32; ++i) { const int kk = 2 * i + (lane >> 5); scr[kk * 33 + (lane & 31)] = W[(size_t)(k0 + kk) * N + n0 + (lane & 31)]; }
    asm volatile("s_waitcnt lgkmcnt(0)" ::: "memory");
    const int c = lane & 7;
#pragma unroll
    for (int j = 0; j < 4; ++j) { const int n = (lane >> 3) + 8 * j; const LAS float* s = scr + (8 * c) * 33 + n;
        u32x4 o; o.x = pk2(s[0 * 33], s[1 * 33]); o.y = pk2(s[2 * 33], s[3 * 33]); o.z = pk2(s[4 * 33], s[5 * 33]); o.w = pk2(s[6 * 33], s[7 * 33]);
        *(u32x4*)(WT + (size_t)(pn0 + n) * K + k0 + 8 * c) = o; }
    asm volatile("s_waitcnt lgkmcnt(0)" ::: "memory");
}

__device__ __forceinline__ void p0_prologue(const Params& P, LAS unsigned char* lds, int gw, int NGW, int gtid, int NGT, int wave, int lane) {
    unsigned char* ws = P.ws;
    LAS float* scr = (LAS float*)(lds + wave * 16384);
    constexpr int I_IN = (D / 64) * (NIN / 32), I_PB = (256 / 64) * (D / 32), I_O = (D / 64) * (D / 32), I_UP = (D / 64) * (FF / 32), I_DN = (FF / 64) * (D / 32);
    constexpr int NITEMS = I_IN + I_PB + I_O + I_UP + I_DN;
    for (int it = gw; it < NITEMS; it += NGW) {
        int r = it;
        if (r < I_IN) { p0_transpose_item<true>(P.w_in, D, NIN, (bf16_t*)(ws + WS_WIN), scr, r, lane); continue; } r -= I_IN;
        if (r < I_PB) { p0_transpose_item<false>(P.w_pb, 256, D, (bf16_t*)(ws + WS_WPB), scr, r, lane); continue; } r -= I_PB;
        if (r < I_O) { p0_transpose_item<false>(P.w_o, D, D, (bf16_t*)(ws + WS_WO), scr, r, lane); continue; } r -= I_O;
        if (r < I_UP) { p0_transpose_item<false>(P.w_up, D, FF, (bf16_t*)(ws + WS_WUP), scr, r, lane); continue; } r -= I_UP;
        p0_transpose_item<false>(P.w_down, FF, D, (bf16_t*)(ws + WS_WDN), scr, r, lane);
    }
    {
        bf16_t* WE = (bf16_t*)(ws + WS_WEFF);
        for (int wi = gw; wi < 1024; wi += NGW) {
            const int ch = __builtin_amdgcn_readfirstlane(wi >> 4), d = (wi & 15) * 64 + lane, g = ch >> 4, c0 = (ch & 15) * 8;
            float a[8];
#pragma unroll
            for (int i = 0; i < 8; ++i) a[i] = 0.f;
            const float* lin = P.pool_lin + (size_t)(g * 128 + c0) * 128; const float* wp = P.w_pa + (size_t)(g * 128) * 1024 + d; const float* sc = P.pool_scale + g * 128;
#pragma unroll 16
            for (int e = 0; e < 128; ++e) { const float wv = wp[(size_t)e * 1024] * sc[e];
#pragma unroll
                for (int i = 0; i < 8; ++i) a[i] += lin[i * 128 + e] * wv; }
            u32x4 o; o.x = pk2(a[0], a[1]); o.y = pk2(a[2], a[3]); o.z = pk2(a[4], a[5]); o.w = pk2(a[6], a[7]);
            *(u32x4*)(WE + (size_t)d * 512 + g * 128 + c0) = o;
        }
    }
    {
        bf16_t* U = (bf16_t*)(ws + WS_U);
        f32x4 lw[4];
#pragma unroll
        for (int j = 0; j < 4; ++j) lw[j] = ((const f32x4*)P.ln1)[lane + 64 * j];
        for (int m0 = gw * 4; m0 < M; m0 += NGW * 4) {
            f32x4 v[4][4];
#pragma unroll
            for (int rr = 0; rr < 4; ++rr) { const int m = m0 + rr; const f32x4* xr = (const f32x4*)(m < MP ? P.xp + (size_t)m * D : P.xs + (size_t)(m - MP) * D) + lane;
#pragma unroll
                for (int j = 0; j < 4; ++j) v[rr][j] = __builtin_nontemporal_load(xr + 64 * j); }
#pragma unroll
            for (int rr = 0; rr < 4; ++rr) { float sq = 0.f;
#pragma unroll
                for (int j = 0; j < 4; ++j) sq += dot4(v[rr][j], v[rr][j]);
                const float rstd = __builtin_amdgcn_rsqf(wave_sum(sq) * (1.f / D) + EPS);
                u32x2* o8 = (u32x2*)(U + (size_t)(m0 + rr) * D) + lane;
#pragma unroll
                for (int j = 0; j < 4; ++j) { const f32x4 y = v[rr][j] * rstd * lw[j]; u32x2 o; o.x = cvt_pk_bf16(y[0], y[1]); o.y = cvt_pk_bf16(y[2], y[3]); o8[64 * j] = o; } }
        }
    }
}
constexpr int CW_COPY = 3584, CW_DONE = 3648;
constexpr int CH4 = 4096;
constexpr int NCH0 = SB * 120 * 128 / CH4, NCH1 = SB * 504 * 128 / CH4, NCH2 = SB * 2040 * 128 / CH4, NCHUNK = NCH0 + NCH1 + NCH2;
template <int G_> __device__ __forceinline__ void copy_chunk_g(const Params& P, int cl, int tid) {
    constexpr int Lw = 128 << (2 * G_), per_b = (Lw - 8) * 128;
    const f32x4* src = (const f32x4*)(G_ == 0 ? P.cache0 : (G_ == 1 ? P.cache1 : P.cache2)); f32x4* dst = (f32x4*)(P.out + o_kvs(G_));
    f32x4 v[8]; unsigned di[8];
#pragma unroll
    for (int k = 0; k < 8; ++k) { const unsigned f = (unsigned)cl * CH4 + tid + 512 * k, b = f / (unsigned)per_b, rem = f - b * per_b; di[k] = b * (Lw * 128) + rem; v[k] = __builtin_nontemporal_load(src + di[k] + 1024); }
#pragma unroll
    for (int k = 0; k < 8; ++k) __builtin_nontemporal_store(v[k], dst + di[k]);
}
__device__ __forceinline__ void copy_chunk(const Params& P, int c, int tid) {
    if (c < NCH0) copy_chunk_g<0>(P, c, tid); else if (c < NCH0 + NCH1) copy_chunk_g<1>(P, c - NCH0, tid); else copy_chunk_g<2>(P, c - NCH0 - NCH1, tid);
}
__device__ __forceinline__ void copy_fill(const Params& P, volatile LAS unsigned* MISC, int w, int tid, int G) {
    unsigned* ctl = (unsigned*)P.ws;
    __syncthreads();
    if (tid == 0) __hip_atomic_fetch_add(ctl + CW_DONE + 64 * w, 1u, __ATOMIC_RELAXED, __HIP_MEMORY_SCOPE_AGENT);
    for (;;) {
        if (tid == 0) { int c = -1;
            if (__hip_atomic_load(ctl + CW_DONE + 64 * w, __ATOMIC_RELAXED, __HIP_MEMORY_SCOPE_AGENT) < (unsigned)G) { const unsigned n = __hip_atomic_fetch_add(ctl + CW_COPY, 1u, __ATOMIC_RELAXED, __HIP_MEMORY_SCOPE_AGENT); if (n < (unsigned)NCHUNK) c = (int)n; }
            MISC[16] = (unsigned)c; }
        __syncthreads();
        const int c = (int)MISC[16];
        __syncthreads();
        if (c < 0) break;
        copy_chunk(P, c, tid);
    }
}
__device__ __forceinline__ void copy_rest(const Params& P, volatile LAS unsigned* MISC, int tid) {
    unsigned* ctl = (unsigned*)P.ws;
    for (;;) {
        if (tid == 0) { const unsigned n = __hip_atomic_fetch_add(ctl + CW_COPY, 1u, __ATOMIC_RELAXED, __HIP_MEMORY_SCOPE_AGENT); MISC[16] = n < (unsigned)NCHUNK ? n : 0xffffffffu; }
        __syncthreads();
        const int c = (int)MISC[16];
        __syncthreads();
        if (c < 0) break;
        copy_chunk(P, c, tid);
    }
}
__device__ __forceinline__ void copy_pool_state(const Params& P, int gtid, int NGT) {
    const f32x4* src = (const f32x4*)P.state_pool; f32x4* dst = (f32x4*)(P.out + O_POOLS);
    for (int i = gtid; i < SB * 7 * 128; i += NGT) { const int b = i / (7 * 128), rem = i - b * 7 * 128; dst[(size_t)b * 15 * 128 + rem] = src[(size_t)b * 15 * 128 + 8 * 128 + rem]; }
}
template <int W> __device__ __forceinline__ void pool_diff_item(const Params& P, int rq, int gidx, int lane) {
    const bf16_t* A = (const bf16_t*)(P.ws + WS_A); bf16_t* DF = (bf16_t*)(P.ws + WS_DIFF);
    const int row = rq * 4 + (lane >> 4), c0 = gidx * 128 + (lane & 15) * 8;
    f32x4 s0 = {0.f, 0.f, 0.f, 0.f}, s1 = {0.f, 0.f, 0.f, 0.f}, a0, a1; float inv;
    if (row < MP) { const int t = row & 2047; const int cnt = (t + 1 < W) ? t + 1 : W; inv = 1.0f / (float)cnt;
        u32x4 x[W];
#pragma unroll
        for (int j = 0; j < W; ++j) x[j] = *(const u32x4*)(A + (size_t)(row - (j <= t ? j : 0)) * 512 + c0);
        unpack8(x[0], a0, a1);
#pragma unroll
        for (int j = 0; j < W; ++j) { f32x4 y0, y1; unpack8(x[j], y0, y1); if (j <= t) { s0 += y0; s1 += y1; } } }
    else { const int sr = row - MP, b = sr >> 3, t = sr & 7; inv = 1.0f / (float)W;
        unpack8(*(const u32x4*)(A + (size_t)row * 512 + c0), a0, a1);
#pragma unroll
        for (int j = 0; j < W; ++j) { const int tt = t - j; f32x4 x0, x1;
            if (tt >= 0) unpack8(*(const u32x4*)(A + (size_t)(row - j) * 512 + c0), x0, x1);
            else { const float* sp = P.state_pool + (size_t)(b * 15 + 15 + tt) * 512 + c0; x0 = *(const f32x4*)sp; x1 = *(const f32x4*)(sp + 4); }
            s0 += x0; s1 += x1; } }
    *(u32x4*)(DF + (size_t)row * 512 + c0) = pack8(s0 * inv - a0, s1 * inv - a1);
}
template <int W> __device__ __forceinline__ void pool_diff_block(const Params& P, int blk, int gidx, int lane) {
    const bf16_t* A = (const bf16_t*)(P.ws + WS_A); bf16_t* DF = (bf16_t*)(P.ws + WS_DIFF);
    const int row0 = blk * 64 + (lane >> 4) * 16, t0 = row0 & 2047, c0 = gidx * 128 + (lane & 15) * 8;
    const bf16_t* ap = A + (size_t)row0 * 512 + c0;
    u32x4 x[16 + W - 1];
#pragma unroll
    for (int k = 0; k < 16 + W - 1; ++k) { const int dt = k - (W - 1); x[k] = (t0 + dt >= 0) ? *(const u32x4*)(ap + dt * 512) : (u32x4){0u, 0u, 0u, 0u}; }
    f32x4 s0 = {0.f, 0.f, 0.f, 0.f}, s1 = {0.f, 0.f, 0.f, 0.f};
#pragma unroll
    for (int k = 0; k < W - 1; ++k) { f32x4 y0, y1; unpack8(x[k], y0, y1); s0 += y0; s1 += y1; }
#pragma unroll
    for (int i = 0; i < 16; ++i) { f32x4 a0, a1, z0, z1; unpack8(x[W - 1 + i], a0, a1); s0 += a0; s1 += a1;
        const int t = t0 + i; const float inv = 1.0f / (float)((t + 1 < W) ? t + 1 : W);
        *(u32x4*)(DF + (size_t)(row0 + i) * 512 + c0) = pack8(s0 * inv - a0, s1 * inv - a1);
        unpack8(x[i], z0, z1); s0 -= z0; s1 -= z1; }
}
__device__ __forceinline__ void pool_diff(const Params& P, int gw, int NGW, int lane) {
    for (int wi = gw; wi < (MP / 64) * 4; wi += NGW) { const int blk = wi >> 2, gidx = wi & 3;
        if (gidx == 0) pool_diff_block<2>(P, blk, 0, lane); else if (gidx == 1) pool_diff_block<4>(P, blk, 1, lane); else if (gidx == 2) pool_diff_block<8>(P, blk, 2, lane); else pool_diff_block<16>(P, blk, 3, lane); }
    for (int wi = gw; wi < MS; wi += NGW) { const int rq = (MP >> 2) + (wi >> 2), gidx = wi & 3;
        if (gidx == 0) pool_diff_item<2>(P, rq, 0, lane); else if (gidx == 1) pool_diff_item<4>(P, rq, 1, lane); else if (gidx == 2) pool_diff_item<8>(P, rq, 2, lane); else pool_diff_item<16>(P, rq, 3, lane); }
}
typedef short s16x4 __attribute__((ext_vector_type(4)));
__device__ __forceinline__ s16x4 vtr(const LAS unsigned char* p) { return __builtin_bit_cast(s16x4, __builtin_amdgcn_ds_read_tr16_b64_v4i16((LAS s16x4*)p)); }
__device__ __forceinline__ void attn_prompt_unit(const Params& P, LAS unsigned char* vl, int u, int lane) {
    const int g = u >> 13; int rem = u & 8191; const int b = rem >> 8; rem &= 255; const int h = rem >> 6; const int idx = rem & 63;
    const int sh = 2 * g, L = 2048 >> sh, tsh = 6 - sh;
    const int r = idx >> tsh, qt = idx & ((1 << tsh) - 1), mq0 = qt * 32;
    const int ql = lane & 15, q = lane >> 4;
    const size_t hb = (size_t)b * 524288 + (size_t)r * (L * 256) + (size_t)h * (L * 64);
    const bf16_t* Qb = (const bf16_t*)(P.ws + WS_QG) + (size_t)g * M * 256 + hb; const bf16_t* Kb = (const bf16_t*)(P.ws + WS_KG) + (size_t)g * MP * 256 + hb; const bf16_t* Vb = (const bf16_t*)(P.ws + WS_VT) + (size_t)g * MP * 256 + hb;
    const float NEG = -1e30f;
    bf16x8 qf[2][2];
#pragma unroll
    for (int a = 0; a < 2; ++a) { const bf16_t* qp = Qb + (mq0 + 16 * a + ql) * 64 + 8 * q; qf[a][0] = *(const bf16x8*)qp; qf[a][1] = *(const bf16x8*)(qp + 32); }
    const int krow = 8 * (ql >> 2) + (ql & 3);
    f32x4 s[2][5][2];
#pragma unroll
    for (int c = 0; c < 5; ++c) { const int kc0 = mq0 - 128 + 32 * c;
        if (kc0 >= 0) {
            bf16x8 kf[2][2];
#pragma unroll
            for (int tt = 0; tt < 2; ++tt) { const bf16_t* kp = Kb + (kc0 + krow + 4 * tt) * 64 + 8 * q; kf[tt][0] = *(const bf16x8*)kp; kf[tt][1] = *(const bf16x8*)(kp + 32); }
#pragma unroll
            for (int a = 0; a < 2; ++a)
#pragma unroll
                for (int tt = 0; tt < 2; ++tt) { f32x4 x = {0.f, 0.f, 0.f, 0.f}; x = __builtin_amdgcn_mfma_f32_16x16x32_bf16(kf[tt][0], qf[a][0], x, 0, 0, 0); x = __builtin_amdgcn_mfma_f32_16x16x32_bf16(kf[tt][1], qf[a][1], x, 0, 0, 0);
                    const int d0 = (mq0 + 16 * a + ql) - (kc0 + 8 * q + 4 * tt);
                    if (c == 0 || c == 4) {
#pragma unroll
                        for (int i = 0; i < 4; ++i) if ((unsigned)(d0 - i) > 128u) x[i] = NEG; }
                    s[a][c][tt] = x; }
        } else {
#pragma unroll
            for (int a = 0; a < 2; ++a) { s[a][c][0] = (f32x4){NEG, NEG, NEG, NEG}; s[a][c][1] = s[a][c][0]; }
        } }
    u32x4 vr[5][4];
#pragma unroll
    for (int c = 0; c < 4; ++c) { const int kc0 = mq0 - 128 + 32 * c;
        if (kc0 >= 0) {
#pragma unroll
            for (int k = 0; k < 4; ++k) { const int p = lane + 64 * k; vr[c][k] = *(const u32x4*)(Vb + (kc0 + (p >> 3)) * 64 + (p & 7) * 8); } } }
    float mx[2], l[2];
#pragma unroll
    for (int a = 0; a < 2; ++a) { float m_ = NEG;
#pragma unroll
        for (int c = 0; c < 5; ++c)
#pragma unroll
            for (int tt = 0; tt < 2; ++tt) m_ = fmaxf(m_, fmaxf(fmaxf(s[a][c][tt][0], s[a][c][tt][1]), fmaxf(s[a][c][tt][2], s[a][c][tt][3])));
        m_ = fmaxf(m_, __shfl_xor(m_, 16)); m_ = fmaxf(m_, __shfl_xor(m_, 32));
        float l_ = 0.f;
#pragma unroll
        for (int c = 0; c < 5; ++c)
#pragma unroll
            for (int tt = 0; tt < 2; ++tt)
#pragma unroll
                for (int i = 0; i < 4; ++i) { const float p = __builtin_amdgcn_exp2f(s[a][c][tt][i] - m_); s[a][c][tt][i] = p; l_ += p; }
        l_ += __shfl_xor(l_, 16); l_ += __shfl_xor(l_, 32);
        mx[a] = m_; l[a] = l_; }
    f32x4 o[2][4];
#pragma unroll
    for (int a = 0; a < 2; ++a)
#pragma unroll
        for (int dt = 0; dt < 4; ++dt) o[a][dt] = (f32x4){0.f, 0.f, 0.f, 0.f};
#pragma unroll
    for (int c = 0; c < 5; ++c) { const int kc0 = mq0 - 128 + 32 * c;
        if (c == 1) {
#pragma unroll
            for (int k = 0; k < 4; ++k) { const int p = lane + 64 * k; vr[4][k] = *(const u32x4*)(Vb + (mq0 + (p >> 3)) * 64 + (p & 7) * 8); } }
        if (kc0 >= 0) {
            asm volatile("" ::: "memory");
#pragma unroll
            for (int k = 0; k < 4; ++k) { const int p = lane + 64 * k; *(LAS u32x4*)(vl + (p >> 3) * 144 + (p & 7) * 16) = vr[c][k]; }
            asm volatile("s_waitcnt lgkmcnt(0)" ::: "memory");
            bf16x8 pb[2];
#pragma unroll
            for (int a = 0; a < 2; ++a) { u32x4 pw; pw.x = cvt_pk_bf16(s[a][c][0][0], s[a][c][0][1]); pw.y = cvt_pk_bf16(s[a][c][0][2], s[a][c][0][3]); pw.z = cvt_pk_bf16(s[a][c][1][0], s[a][c][1][1]); pw.w = cvt_pk_bf16(s[a][c][1][2], s[a][c][1][3]); pb[a] = __builtin_bit_cast(bf16x8, pw); }
#pragma unroll
            for (int dt = 0; dt < 4; ++dt) { const LAS unsigned char* tp = vl + (8 * q + (ql >> 2)) * 144 + (16 * dt + 4 * (ql & 3)) * 2;
                const s16x4 t0 = vtr(tp), t1 = vtr(tp + 4 * 144);
                const bf16x8 vf = {t0[0], t0[1], t0[2], t0[3], t1[0], t1[1], t1[2], t1[3]};
#pragma unroll
                for (int a = 0; a < 2; ++a) o[a][dt] = __builtin_amdgcn_mfma_f32_16x16x32_bf16(vf, pb[a], o[a][dt], 0, 0, 0); }
            asm volatile("" ::: "memory");
        } }
#pragma unroll
    for (int a = 0; a < 2; ++a) { const float il = 1.0f / l[a];
        const int tok = b * 2048 + (mq0 + 16 * a + ql) * (1 << sh) + r;
        bf16_t* og = (bf16_t*)(P.ws + WS_OG) + ((size_t)g * MP + tok) * 256 + h * 64 + 4 * q;
#pragma unroll
        for (int dt = 0; dt < 4; ++dt) { u32x2 w; w.x = cvt_pk_bf16(o[a][dt][0] * il, o[a][dt][1] * il); w.y = cvt_pk_bf16(o[a][dt][2] * il, o[a][dt][3] * il); *(u32x2*)(og + dt * 16) = w; }
        if (q == 0) ((float*)(P.ws + WS_LSE))[((size_t)g * MP + tok) * 4 + h] = mx[a] + __builtin_amdgcn_logf(l[a]); }
}
__device__ __forceinline__ void attn_sample_item(const Params& P, int it, int lane) {
    const int b = it >> 5, t = (it >> 2) & 7, h = it & 3, kg = lane >> 4, dl = lane & 15;
    float m = -1e30f, l = 0.f; f32x4 acc = {0.f, 0.f, 0.f, 0.f};
#pragma unroll 1
    for (int g = 0; g < 3; ++g) {
        const int sh = 2 * g, dil = 1 << sh, Lw = 128 << sh;
        const u32x2 qw = *(const u32x2*)((const bf16_t*)(P.ws + WS_QG) + (size_t)g * M * 256 + (size_t)(MP + b * 8 + t) * 256 + h * 64 + 4 * dl);
        const f32x4 q4 = {bflo(qw.x), bfhi(qw.x), bflo(qw.y), bfhi(qw.y)};
        const float* cache = (g == 0 ? P.cache0 : (g == 1 ? P.cache1 : P.cache2)) + (size_t)b * Lw * 512; const float* newr = P.out + o_kvs(g) + (size_t)b * Lw * 512;
#pragma unroll 1
        for (int bt = 0; bt < 3; ++bt) {
            asm volatile("" ::: "memory");
            f32x4 k4[11], v4[11];
#pragma unroll
            for (int u = 0; u < 11; ++u) { const int j = 4 * (bt * 11 + u) + kg; const int jj = j <= 128 ? j : 128; const int idx = Lw + t - jj * dil;
                const float* rowp = (idx < Lw ? cache + (size_t)idx * 512 : newr + (size_t)(idx - 8) * 512) + h * 64 + 4 * dl;
                k4[u] = *(const f32x4*)rowp; v4[u] = *(const f32x4*)(rowp + 256); }
#pragma unroll
            for (int u = 0; u < 11; ++u) { const int j = 4 * (bt * 11 + u) + kg;
                float s = dot4(q4, k4[u]); s += __shfl_xor(s, 1); s += __shfl_xor(s, 2); s += __shfl_xor(s, 4); s += __shfl_xor(s, 8);
                if (j > 128) s = -1e30f;
                const float mn = fmaxf(m, s), al = __builtin_amdgcn_exp2f(m - mn), p = __builtin_amdgcn_exp2f(s - mn);
                l = l * al + p; acc = acc * al + v4[u] * p; m = mn; }
        }
    }
    float mm = fmaxf(m, __shfl_xor(m, 16)); mm = fmaxf(mm, __shfl_xor(mm, 32));
    const float f = __builtin_amdgcn_exp2f(m - mm); l *= f; acc = acc * f;
    l += __shfl_xor(l, 16); l += __shfl_xor(l, 32);
#pragma unroll
    for (int i = 0; i < 4; ++i) { acc[i] += __shfl_xor(acc[i], 16); acc[i] += __shfl_xor(acc[i], 32); }
    if (kg == 0) { const float il = 1.0f / l; u32x2 w; w.x = cvt_pk_bf16(acc[0] * il, acc[1] * il); w.y = cvt_pk_bf16(acc[2] * il, acc[3] * il);
        *(u32x2*)((bf16_t*)(P.ws + WS_ATTN) + (size_t)(MP + b * 8 + t) * 256 + h * 64 + 4 * dl) = w; }
}
__device__ __forceinline__ void attn_combine(const Params& P, int gtid, int NGT) {
    const bf16_t* OG = (const bf16_t*)(P.ws + WS_OG); const float* LSE = (const float*)(P.ws + WS_LSE); bf16_t* AT = (bf16_t*)(P.ws + WS_ATTN);
    for (int it = gtid; it < MP * 32; it += NGT) { const int row = it >> 5, c8 = it & 31, h = c8 >> 3;
        const float l0 = LSE[((size_t)0 * MP + row) * 4 + h], l1 = LSE[((size_t)1 * MP + row) * 4 + h], l2 = LSE[((size_t)2 * MP + row) * 4 + h];
        const float mx = fmaxf(l0, fmaxf(l1, l2)); float w0 = __builtin_amdgcn_exp2f(l0 - mx), w1 = __builtin_amdgcn_exp2f(l1 - mx), w2 = __builtin_amdgcn_exp2f(l2 - mx);
        const float inv = 1.0f / (w0 + w1 + w2); w0 *= inv; w1 *= inv; w2 *= inv;
        f32x4 a0, a1, b0, b1, c0, c1;
        unpack8(*(const u32x4*)(OG + ((size_t)0 * MP + row) * 256 + c8 * 8), a0, a1); unpack8(*(const u32x4*)(OG + ((size_t)1 * MP + row) * 256 + c8 * 8), b0, b1); unpack8(*(const u32x4*)(OG + ((size_t)2 * MP + row) * 256 + c8 * 8), c0, c1);
        *(u32x4*)(AT + (size_t)row * 256 + c8 * 8) = pack8(a0 * w0 + b0 * w1 + c0 * w2, a1 * w0 + b1 * w1 + c1 * w2); }
}

#define XB_TMO      128
#define XB_XCNT(j)  (256  + 64 * (j))
#define XB_XSUB(j)  (1280 + 64 * (j))
#define XB_XGEN(j)  (2304 + 64 * (j))
#define XB_TOP      3328
#define XB_TOPGEN   3392
#define XCD_BAR_WORDS 3456
#define XB_SPIN_CAP (1u << 18)

__device__ __forceinline__ unsigned xb_ld(unsigned* p)              { return __hip_atomic_load(p, __ATOMIC_RELAXED, __HIP_MEMORY_SCOPE_AGENT); }
__device__ __forceinline__ unsigned xb_add(unsigned* p, unsigned v) { return __hip_atomic_fetch_add(p, v, __ATOMIC_RELAXED, __HIP_MEMORY_SCOPE_AGENT); }
__device__ __forceinline__ unsigned xb_xcc_id() { return (unsigned)__builtin_amdgcn_s_getreg((3 << 11) | 20) & 0xFu; }
#define XB_SPIN(cond, bar) do { unsigned _sp = 0; while (cond) { __builtin_amdgcn_s_sleep(1); \
    if ((++_sp & 255u) == 0u) { if (xb_ld(&(bar)[XB_TMO])) break; if (_sp > XB_SPIN_CAP) { atomicAdd(&(bar)[XB_TMO], 1u); break; } } } } while (0)

struct XcdBarrier {
    unsigned* bar; unsigned x;
    volatile LAS unsigned* st;
};

__device__ __forceinline__ XcdBarrier xcd_barrier_post(unsigned* bar, volatile LAS unsigned* st) {
    XcdBarrier b; b.bar = bar; b.x = xb_xcc_id(); b.st = st;
    if (threadIdx.x == 0) (void)xb_add(&bar[XB_XCNT(b.x)], 1u);
    return b;
}
__device__ __forceinline__ void xcd_barrier_complete(unsigned* bar, unsigned x, unsigned& nloc, unsigned& nx) {
    const unsigned G = gridDim.x * gridDim.y * gridDim.z;
    unsigned sum, cnt, mine, sp = 0u;
    for (;;) {
        sum = 0u; cnt = 0u; mine = 0u;
#pragma unroll
        for (unsigned j = 0; j < 16; ++j) { const unsigned c = xb_ld(&bar[XB_XCNT(j)]); sum += c; cnt += (c > 0u) ? 1u : 0u; mine = (j == x) ? c : mine; }
        if (sum == G) break;
        __builtin_amdgcn_s_sleep(1);
        if ((++sp & 255u) == 0u) { if (xb_ld(&bar[XB_TMO])) break; if (sp > XB_SPIN_CAP) { atomicAdd(&bar[XB_TMO], 1u); break; } }
    }
    nloc = mine > 0u ? mine : 1u; nx = cnt > 0u ? cnt : 1u;
}

__device__ __forceinline__ void xcd_barrier(const XcdBarrier& b) {
    asm volatile("s_waitcnt vmcnt(0)" ::: "memory");
    __syncthreads();
    if (threadIdx.x == 0) {
        unsigned* bar = b.bar;
        __builtin_amdgcn_s_waitcnt(0);
        unsigned nloc = b.st[0], nx = b.st[1];
        if (nloc == 0u) { xcd_barrier_complete(bar, b.x, nloc, nx); b.st[0] = nloc; b.st[1] = nx; }
        const unsigned old = xb_add(&bar[XB_XSUB(b.x)], 1u);
        const unsigned gen = old / nloc;
        if (old + 1u == (gen + 1u) * nloc) {
            __builtin_amdgcn_fence(__ATOMIC_RELEASE, "agent");
            asm volatile("s_waitcnt vmcnt(0)" ::: "memory");
            const unsigned og = xb_add(&bar[XB_TOP], 1u);
            const unsigned tg = og / nx;
            if (og + 1u == (tg + 1u) * nx) xb_add(&bar[XB_TOPGEN], 1u);
            else XB_SPIN(xb_ld(&bar[XB_TOPGEN]) == tg, bar);
            __builtin_amdgcn_fence(__ATOMIC_ACQUIRE, "agent");
            xb_add(&bar[XB_XGEN(b.x)], 1u);
            asm volatile("s_waitcnt vmcnt(0)" ::: "memory");
        } else {
            XB_SPIN(xb_ld(&bar[XB_XGEN(b.x)]) == gen, bar);
            __builtin_amdgcn_fence(__ATOMIC_ACQUIRE, "agent");
            asm volatile("s_waitcnt vmcnt(0)" ::: "memory");
        }
    }
    __syncthreads();
}

constexpr int LDS_BYTES = 131072 + 1024;
__global__ void __launch_bounds__(512, 2) fwd_megakernel(Params P) {
    extern __shared__ __attribute__((aligned(16))) unsigned char lds_raw[];
    LAS unsigned char* lds = (LAS unsigned char*)lds_raw;
    const int tid = threadIdx.x, lane = tid & 63, wave = __builtin_amdgcn_readfirstlane(tid >> 6);
    volatile LAS unsigned* MISC = (volatile LAS unsigned*)(lds + 131072);
    if (tid < 64) MISC[tid] = 0u;
    __syncthreads();
    if (P.ws == nullptr) cg::this_grid().sync();
    XcdBarrier xbar = xcd_barrier_post((unsigned*)P.ws, MISC + 8);
    const int G = gridDim.x, bx = blockIdx.x;
    const int gw = bx * 8 + wave, NGW = G * 8, gtid = bx * 512 + tid, NGT = G * 512;
    unsigned char* ws = P.ws;
    p0_prologue(P, lds, gw, NGW, gtid, NGT, wave, lane);
    copy_pool_state(P, gtid, NGT);
    xcd_barrier(xbar);
    { pg8::Gemm g{(const bf16_t*)(ws + WS_U), (const bf16_t*)(ws + WS_WIN), M, NIN, D}; pg8::StaticOrder S; S.init(M, NIN, G, bx);
      EpiIn E{(bf16_t*)(ws + WS_A), (bf16_t*)(ws + WS_QG), (bf16_t*)(ws + WS_KG), (bf16_t*)(ws + WS_VT), (bf16_t*)(ws + WS_GA), (bf16_t*)(ws + WS_GB), P.out, P.q_norm, P.k_norm};
      pg8::gemm_phase<EpiIn, pg8::StaticOrder, true, true>(lds, g, S, E); }
    xcd_barrier(xbar);
    {
        const int npu = (3 * 8192 - gw + NGW - 1) / NGW, nsi = gw < 4096 ? (4096 - gw + NGW - 1) / NGW : 0, first_s = (bx & 1) ? 0 : npu;
#pragma unroll 1
        for (int i = 0; i < npu + nsi; ++i) {
            if (i >= first_s && i < first_s + nsi) attn_sample_item(P, gw + (i - first_s) * NGW, lane);
            else attn_prompt_unit(P, lds + wave * 4608, gw + (i < first_s ? i : i - nsi) * NGW, lane);
        }
    }
    pool_diff(P, gw, NGW, lane);
    xcd_barrier(xbar);
    { pg8::Gemm g{(const bf16_t*)(ws + WS_DIFF), (const bf16_t*)(ws + WS_WEFF), M, D, 512}; pg8::StaticOrder S; S.init(M, D, G, bx);
      EpiGate<true> E{(const bf16_t*)(ws + WS_GA), (bf16_t*)(ws + WS_MIX)};
      pg8::gemm_phase<EpiGate<true>, pg8::StaticOrder, true, true>(lds, g, S, E); }
    attn_combine(P, gtid, NGT);
    xcd_barrier(xbar);
    { pg8::Gemm g{(const bf16_t*)(ws + WS_ATTN), (const bf16_t*)(ws + WS_WPB), M, D, 256}; pg8::StaticOrder S; S.init(M, D, G, bx);
      EpiGate<false> E{(const bf16_t*)(ws + WS_GB), (bf16_t*)(ws + WS_MIX)};
      pg8::gemm_phase<EpiGate<false>, pg8::StaticOrder, true, true>(lds, g, S, E); }
    xcd_barrier(xbar);
    { pg8::Gemm g{(const bf16_t*)(ws + WS_MIX), (const bf16_t*)(ws + WS_WO), M, D, D}; pg8::StaticOrder S; S.init(M, D, G, bx);
      EpiH E{P.xp, P.xs, P.ln2, P.out + O_Y, (bf16_t*)(ws + WS_HN), (float*)(ws + WS_SSP)};
      pg8::gemm_phase<EpiH, pg8::StaticOrder, true, true>(lds, g, S, E); }
    xcd_barrier(xbar);
    { pg8::Gemm g{(const bf16_t*)(ws + WS_HN), (const bf16_t*)(ws + WS_WUP), M, FF, D}; pg8::StaticOrder S; S.init(M, FF, G, bx);
      EpiUp E{(const float*)(ws + WS_SSP), (bf16_t*)(ws + WS_Z)};
      pg8::gemm_phase<EpiUp, pg8::StaticOrder, true, true>(lds, g, S, E); }
    xcd_barrier(xbar);
    { pg8::Gemm g{(const bf16_t*)(ws + WS_Z), (const bf16_t*)(ws + WS_WDN), M, D, FF}; pg8::StaticOrder S; S.init(M, D, G, bx);
      EpiDown E{P.out + O_Y};
      pg8::gemm_phase<EpiDown, pg8::StaticOrder, true, true>(lds, g, S, E); }
    copy_rest(P, MISC, tid);
}
}

extern "C" void kernel_launch(void* const* d_in, const int* in_sizes, int n_in, void* d_out, int out_size, void* d_ws, size_t ws_size, hipStream_t stream) {
    using namespace mk;
    static int grid = 0;
    if (grid == 0) {
        if (n_in != 18 || (size_t)out_size != O_END || ws_size < WS_END) { fprintf(stderr, "kernel_launch: unexpected sizes: n_in %d out %d (want %zu) ws %zu (want %zu)\n", n_in, out_size, (size_t)O_END, ws_size, (size_t)WS_END); grid = -1; return; }
        int dev = 0, cus = 0, per_cu = 0;
        if (hipGetDevice(&dev) != hipSuccess || hipDeviceGetAttribute(&cus, hipDeviceAttributeMultiprocessorCount, dev) != hipSuccess) { grid = -1; return; }
        if (hipFuncSetAttribute((const void*)fwd_megakernel, hipFuncAttributeMaxDynamicSharedMemorySize, LDS_BYTES) != hipSuccess) { fprintf(stderr, "kernel_launch: hipFuncSetAttribute failed\n"); grid = -1; return; }
        if (hipOccupancyMaxActiveBlocksPerMultiprocessor(&per_cu, (const void*)fwd_megakernel, 512, LDS_BYTES) != hipSuccess || per_cu < 1) { fprintf(stderr, "kernel_launch: occupancy query gave %d\n", per_cu); per_cu = 1; }
        (void)hipGetLastError();
        grid = cus * 1;
    }
    if (grid < 0) return;
    if (hipMemsetAsync(d_ws, 0, 16384, stream) != hipSuccess) { fprintf(stderr, "kernel_launch: memset failed\n"); return; }
    Params p{};
    p.xp = (const float*)d_in[0]; p.xs = (const float*)d_in[1]; p.state_pool = (const float*)d_in[2]; p.cache0 = (const float*)d_in[3]; p.cache1 = (const float*)d_in[4]; p.cache2 = (const float*)d_in[5];
    p.ln1 = (const float*)d_in[6]; p.w_in = (const float*)d_in[7]; p.q_norm = (const float*)d_in[8]; p.k_norm = (const float*)d_in[9]; p.pool_lin = (const float*)d_in[10]; p.pool_scale = (const float*)d_in[11];
    p.w_pa = (const float*)d_in[12]; p.w_pb = (const float*)d_in[13]; p.w_o = (const float*)d_in[14]; p.ln2 = (const float*)d_in[15]; p.w_up = (const float*)d_in[16]; p.w_down = (const float*)d_in[17];
    p.out = (float*)d_out; p.ws = (unsigned char*)d_ws;
    void* args[] = {&p};
    hipError_t e = hipLaunchCooperativeKernel((const void*)fwd_megakernel, dim3(grid), dim3(512), args, LDS_BYTES, stream);
    if (e != hipSuccess) fprintf(stderr, "kernel_launch: cooperative launch failed: %s (grid %d)\n", hipGetErrorString(e), grid);
}
```

```cpp
#include <hip/hip_runtime.h>
#include <hip/hip_cooperative_groups.h>
#include <cstdio>
#include <cstdint>
namespace cg = cooperative_groups;
namespace pg8 {
#define PG8_LAS __attribute__((address_space(3)))
typedef unsigned short bf16_t;
typedef short bf16x8 __attribute__((ext_vector_type(8)));
typedef float f32x4 __attribute__((ext_vector_type(4)));
typedef unsigned u32x4 __attribute__((ext_vector_type(4)));
constexpr int BM = 256, BK = 64, HALF = 128, HTB = HALF * BK * 2  , STAGE_BYTES = 8 * HTB, NXCD = 8, WGM = 8;

__host__ __device__ __forceinline__ int lds_byte(int r, int c) { const int st = (r >> 4) * 2 + (c >> 5), rr = r & 15, cc = c & 31, ob = rr * 64 + cc * 2; return st * 1024 + (ob ^ (((ob >> 9) & 1) << 5)); }
__host__ __device__ __forceinline__ void stage_rc(int b, int& R, int& C) { const int st = b / 1024, sb = b % 1024, swz = sb ^ (((sb >> 9) & 1) << 5); R = (st >> 1) * 16 + swz / 64; C = (st & 1) * 32 + (swz % 64) / 2; }
__host__ __device__ __forceinline__ int perm32(int rho) { const int n = rho >> 4, i = rho & 15; return 8 * (i >> 2) + 4 * n + (i & 3); }

struct Unit { int pm, pn; };
struct Gemm { const bf16_t* A; const bf16_t* Bt; int M, N, K; };

struct StaticOrder {
    int nM, nN, nwg, G, c;
    __host__ __device__ void init(int M, int N, int G_, int c_) { nM = M / BM; nN = N / BM; nwg = nM * nN; G = G_; c = c_; }
    __host__ __device__ bool next(int i, Unit& u) const {
        const long L = (long)i * G + c; if (L >= nwg) return false;
        int wgid = (int)L; { const int q = nwg / NXCD, r = nwg % NXCD, xcd = wgid % NXCD, off = wgid / NXCD; wgid = (xcd < r ? xcd * (q + 1) : r * (q + 1) + (xcd - r) * q) + off; }
        const int nig = WGM * nN, gid = wgid / nig, fm = gid * WGM, gsz = (nM - fm) < WGM ? (nM - fm) : WGM;
        u.pm = fm + ((wgid % nig) % gsz); u.pn = (wgid % nig) / gsz; return true;
    }
    __device__ __forceinline__ void a_ready(const Unit&) const {}
    __device__ __forceinline__ void done(const Unit&) const {}
};

__device__ __forceinline__ unsigned cvt_pk_bf16(float lo, float hi) { unsigned r; asm volatile("v_cvt_pk_bf16_f32 %0, %1, %2" : "=v"(r) : "v"(lo), "v"(hi)); return r; }
typedef float f32x2 __attribute__((ext_vector_type(2)));
template <class Epi, class Sched, bool ALIGN_EPI = false, bool SP2 = false>
__device__ __forceinline__ void gemm_phase(PG8_LAS unsigned char* lds, const Gemm g, const Sched& S, const Epi& E) {
    int tid_ = threadIdx.x; asm volatile("" : "+v"(tid_));
    const int tid = tid_, wid = __builtin_amdgcn_readfirstlane(tid >> 6), lane = tid & 63, wr = wid >> 2, wc = wid & 3, fr = lane & 15, fq = lane >> 4;
    const int K = g.K, nt = K / BK;
    unsigned voffA[2], voffB[2];
#pragma unroll
    for (int i = 0; i < 2; ++i) { int R, C; stage_rc(tid * 16 + i * 8192, R, C); const int Rb = Epi::PERM ? ((R & ~31) + perm32(R & 31)) : R;
        voffA[i] = (unsigned)(R * K + C) * 2u; voffB[i] = (unsigned)(Rb * K + C) * 2u; }
    const size_t kstep = (size_t)(BK * 2);
    const size_t hstep = (size_t)HALF * K * 2;
    const size_t tstep = 2 * hstep;
    const unsigned ldsw = (unsigned)wid * 1024u;
    const int aoff = lds_byte(wr * 64 + fr, fq * 8), boff = lds_byte(wc * 32 + fr, fq * 8);
#define PG8_SA(b, h) (((b) * 2 + (h)) * HTB)
#define PG8_SB(b, h) ((4 + (b) * 2 + (h)) * HTB)
#define PG8_STAGE(bufoff, gbase, voff) do { _Pragma("unroll") for (int _i = 0; _i < 2; ++_i) \
        __builtin_amdgcn_global_load_lds((const unsigned*)((const char*)(gbase) + (voff)[_i]), (PG8_LAS unsigned*)(lds + (bufoff) + ldsw + _i * 8192), 16, 0, 0); } while (0)
#define PG8_LDA(dst, b, h) do { _Pragma("unroll") for (int m = 0; m < 4; ++m) _Pragma("unroll") for (int k = 0; k < 2; ++k) dst[m][k] = *(const PG8_LAS bf16x8*)(lds + PG8_SA(b, h) + aoff + m * 2048 + k * 1024); } while (0)
#define PG8_LDB(dst, b, h) do { _Pragma("unroll") for (int n = 0; n < 2; ++n) _Pragma("unroll") for (int k = 0; k < 2; ++k) dst[n][k] = *(const PG8_LAS bf16x8*)(lds + PG8_SB(b, h) + boff + n * 2048 + k * 1024); } while (0)
#define PG8_MMA(ai, bj, At, Bt) do { __builtin_amdgcn_s_setprio(1); _Pragma("unroll") for (int m = 0; m < 4; ++m) _Pragma("unroll") for (int n = 0; n < 2; ++n) _Pragma("unroll") for (int k = 0; k < 2; ++k) \
        acc[ai][bj][m][n] = __builtin_amdgcn_mfma_f32_16x16x32_bf16(Bt[n][k], At[m][k], acc[ai][bj][m][n], 0, 0, 0); __builtin_amdgcn_s_setprio(0); } while (0)
#define PG8_WAIT_V(n) asm volatile("s_waitcnt vmcnt(" #n ")" ::: "memory")
#define PG8_WAIT_L(n) asm volatile("s_waitcnt lgkmcnt(" #n ")" ::: "memory")
#define PG8_BAR __builtin_amdgcn_s_barrier()
#define PG8_SCHED __builtin_amdgcn_sched_barrier(0)
    Unit cur, nxt; int ui = 0;
    if (!S.next(0, cur)) return;
    f32x4 acc[2][2][4][2];
#pragma unroll
    for (int a = 0; a < 2; ++a)
#pragma unroll
        for (int b = 0; b < 2; ++b)
#pragma unroll
            for (int m = 0; m < 4; ++m)
#pragma unroll
                for (int n = 0; n < 2; ++n) acc[a][b][m][n] = (f32x4){0.f, 0.f, 0.f, 0.f};
    bf16x8 At[4][2], B0[2][2], B1[2][2];
    const char* cA = (const char*)g.A + (size_t)cur.pm * tstep; const char* cB = (const char*)g.Bt + (size_t)cur.pn * tstep;
    S.a_ready(cur);
    if constexpr (SP2) {
        PG8_STAGE(PG8_SB(0, 0), cB, voffB); PG8_STAGE(PG8_SB(0, 1), cB + hstep, voffB); PG8_STAGE(PG8_SA(0, 0), cA, voffA); PG8_STAGE(PG8_SA(0, 1), cA + hstep, voffA);
        if (wr == 1) PG8_BAR;
        PG8_WAIT_V(2); PG8_BAR;
        PG8_STAGE(PG8_SB(1, 0), cB + kstep, voffB); PG8_STAGE(PG8_SA(1, 0), cA + kstep, voffA); PG8_STAGE(PG8_SB(1, 1), cB + hstep + kstep, voffB);
        PG8_WAIT_V(6); PG8_BAR;
    } else {
        PG8_STAGE(PG8_SB(0, 0), cB, voffB); PG8_STAGE(PG8_SA(0, 0), cA, voffA); PG8_STAGE(PG8_SB(0, 1), cB + hstep, voffB); PG8_STAGE(PG8_SA(0, 1), cA + hstep, voffA);
        if (wr == 1) PG8_BAR;
        PG8_WAIT_V(4); PG8_BAR;
        PG8_STAGE(PG8_SB(1, 0), cB + kstep, voffB); PG8_STAGE(PG8_SA(1, 0), cA + kstep, voffA); PG8_STAGE(PG8_SB(1, 1), cB + hstep + kstep, voffB);
        PG8_WAIT_V(6); PG8_BAR;
    }
    for (;;) {
        const bool has_next = S.next(ui + 1, nxt);
        const char* nA = has_next ? (const char*)g.A + (size_t)nxt.pm * tstep : cA; const char* nB = has_next ? (const char*)g.Bt + (size_t)nxt.pn * tstep : cB;
        for (int t = 0; t < nt; t += 2) {
            const bool last = (t == nt - 2);
            const char* a1 = cA + (size_t)(t + 1) * kstep;
            const char* a2 = last ? nA : cA + (size_t)(t + 2) * kstep; const char* b2 = last ? nB : cB + (size_t)(t + 2) * kstep;
            const char* a3 = a2 + kstep; const char* b3 = b2 + kstep;
            if (last && has_next) S.a_ready(nxt);
            if constexpr (SP2) {
            PG8_LDB(B0, 0, 0); PG8_LDB(B1, 0, 1); PG8_SCHED; PG8_LDA(At, 0, 0); PG8_STAGE(PG8_SA(1, 1), a1 + hstep, voffA);
            PG8_WAIT_V(8); PG8_WAIT_L(0); PG8_BAR; PG8_MMA(0, 0, At, B0); PG8_MMA(0, 1, At, B1); PG8_BAR; PG8_SCHED;
            PG8_LDA(At, 0, 1); PG8_STAGE(PG8_SB(0, 0), b2, voffB); PG8_STAGE(PG8_SB(0, 1), b2 + hstep, voffB); PG8_STAGE(PG8_SA(0, 0), a2, voffA);
            PG8_WAIT_V(8); PG8_WAIT_L(0); PG8_BAR; PG8_MMA(1, 0, At, B0); PG8_MMA(1, 1, At, B1); PG8_BAR; PG8_SCHED;
            PG8_LDB(B0, 1, 0); PG8_LDB(B1, 1, 1); PG8_SCHED; PG8_LDA(At, 1, 0); PG8_STAGE(PG8_SA(0, 1), a2 + hstep, voffA);
            PG8_WAIT_V(8); PG8_WAIT_L(0); PG8_BAR; PG8_MMA(0, 0, At, B0); PG8_MMA(0, 1, At, B1); PG8_BAR; PG8_SCHED;
            PG8_LDA(At, 1, 1); PG8_STAGE(PG8_SB(1, 0), b3, voffB); PG8_STAGE(PG8_SB(1, 1), b3 + hstep, voffB); PG8_STAGE(PG8_SA(1, 0), a3, voffA);
            PG8_WAIT_V(8); PG8_WAIT_L(0); PG8_BAR; PG8_MMA(1, 0, At, B0); PG8_MMA(1, 1, At, B1); PG8_BAR; PG8_SCHED;
            } else {
            PG8_LDB(B0, 0, 0); PG8_SCHED; PG8_LDA(At, 0, 0); PG8_STAGE(PG8_SA(1, 1), a1 + hstep, voffA);
            PG8_WAIT_L(8); PG8_BAR; PG8_WAIT_L(0); PG8_MMA(0, 0, At, B0); PG8_BAR; PG8_SCHED;
            PG8_LDB(B1, 0, 1); PG8_STAGE(PG8_SB(0, 0), b2, voffB);
            PG8_BAR; PG8_WAIT_L(0); PG8_MMA(0, 1, At, B1); PG8_BAR;
            PG8_LDA(At, 0, 1); PG8_STAGE(PG8_SA(0, 0), a2, voffA);
            PG8_BAR; PG8_WAIT_L(0); PG8_MMA(1, 0, At, B0); PG8_BAR; PG8_SCHED;
            PG8_STAGE(PG8_SB(0, 1), b2 + hstep, voffB);
            PG8_WAIT_V(6); PG8_BAR; PG8_MMA(1, 1, At, B1); PG8_BAR;
            PG8_LDB(B0, 1, 0); PG8_SCHED; PG8_LDA(At, 1, 0); PG8_STAGE(PG8_SA(0, 1), a2 + hstep, voffA);
            PG8_WAIT_L(8); PG8_BAR; PG8_WAIT_L(0); PG8_MMA(0, 0, At, B0); PG8_BAR; PG8_SCHED;
            PG8_LDB(B1, 1, 1); PG8_STAGE(PG8_SB(1, 0), b3, voffB);
            PG8_BAR; PG8_WAIT_L(0); PG8_MMA(0, 1, At, B1); PG8_BAR;
            PG8_LDA(At, 1, 1); PG8_STAGE(PG8_SA(1, 0), a3, voffA);
            PG8_BAR; PG8_WAIT_L(0); PG8_MMA(1, 0, At, B0); PG8_BAR; PG8_SCHED;
            PG8_STAGE(PG8_SB(1, 1), b3 + hstep, voffB);
            PG8_WAIT_V(6); PG8_BAR; PG8_MMA(1, 1, At, B1); PG8_BAR;
            }
        }
        if constexpr (ALIGN_EPI) { if (wr == 0) PG8_BAR; }
        if constexpr (!Epi::AFTER_DRAIN) { E(acc, cur, wr, wc, fr, fq); S.done(cur); }
        if (!has_next) break;
#pragma unroll
        for (int a = 0; a < 2; ++a)
#pragma unroll
            for (int b = 0; b < 2; ++b)
#pragma unroll
                for (int m = 0; m < 4; ++m)
#pragma unroll
                    for (int n = 0; n < 2; ++n) acc[a][b][m][n] = (f32x4){0.f, 0.f, 0.f, 0.f};
        cur = nxt; cA = nA; cB = nB; ++ui;
        if constexpr (ALIGN_EPI) { if (wr == 1) PG8_BAR; }
    }
    PG8_WAIT_V(0);
    if constexpr (!ALIGN_EPI) { if (wr == 0) PG8_BAR; }
    PG8_BAR;
    if constexpr (Epi::AFTER_DRAIN) { E.fused(acc, cur, wr, wc, fr, fq, lds, wid, lane); S.done(cur); }
#undef PG8_SA
#undef PG8_SB
#undef PG8_STAGE
#undef PG8_LDA
#undef PG8_LDB
#undef PG8_MMA
#undef PG8_WAIT_V
#undef PG8_WAIT_L
#undef PG8_BAR
#undef PG8_SCHED
}
}
namespace mk {
using pg8::bf16_t; using pg8::f32x4; using pg8::u32x4; using pg8::bf16x8; using pg8::Unit; using pg8::cvt_pk_bf16;
typedef unsigned u32x2 __attribute__((ext_vector_type(2)));
#define LAS __attribute__((address_space(3)))
constexpr int D = 1024, SEQ = 2048, NB = 32, MP = NB * SEQ, SB = 128, ST = 8, MS = SB * ST, M = MP + MS;
constexpr int NIN = 4864, FF = 4096, PW = 512;
constexpr float EPS = 1e-6f;
constexpr float QSCALE = 0.125f * 1.4426950408889634f;
constexpr size_t O_Y = 0, O_POOLP = (size_t)M * D, O_KVP0 = O_POOLP + (size_t)NB * 15 * 512, O_KVP1 = O_KVP0 + (size_t)NB * 128 * 512, O_KVP2 = O_KVP1 + (size_t)NB * 512 * 512,
                 O_POOLS = O_KVP2 + (size_t)NB * 2048 * 512, O_KVS0 = O_POOLS + (size_t)SB * 15 * 512, O_KVS1 = O_KVS0 + (size_t)SB * 128 * 512, O_KVS2 = O_KVS1 + (size_t)SB * 512 * 512,
                 O_END = O_KVS2 + (size_t)SB * 2048 * 512;
__host__ __device__ __forceinline__ constexpr size_t o_kvp(int g) { return g == 0 ? O_KVP0 : (g == 1 ? O_KVP1 : O_KVP2); }
__host__ __device__ __forceinline__ constexpr size_t o_kvs(int g) { return g == 0 ? O_KVS0 : (g == 1 ? O_KVS1 : O_KVS2); }
constexpr size_t al1m(size_t x) { return (x + 1048575) & ~(size_t)1048575; }
constexpr size_t WS_WIN = 1048576, WS_WEFF = al1m(WS_WIN + (size_t)NIN * D * 2), WS_WPB = al1m(WS_WEFF + (size_t)D * 512 * 2), WS_WO = al1m(WS_WPB + (size_t)D * 256 * 2),
                 WS_WUP = al1m(WS_WO + (size_t)D * D * 2), WS_WDN = al1m(WS_WUP + (size_t)FF * D * 2), WS_SSP = al1m(WS_WDN + (size_t)FF * D * 2), WS_LSE = al1m(WS_SSP + (size_t)M * 16 * 4),
                 WS_DIFF = al1m(WS_LSE + (size_t)3 * MP * 4 * 4), WS_OG = al1m(WS_DIFF + (size_t)M * 512 * 2), WS_ATTN = al1m(WS_OG + (size_t)3 * MP * 256 * 2),
                 WS_MIX = al1m(WS_ATTN + (size_t)M * 256 * 2), WS_HN = al1m(WS_MIX + (size_t)M * D * 2), WS_BIG = al1m(WS_HN + (size_t)M * D * 2),
                 WS_U = WS_BIG, WS_A = al1m(WS_U + (size_t)M * D * 2), WS_QG = al1m(WS_A + (size_t)M * 512 * 2), WS_KG = al1m(WS_QG + (size_t)3 * M * 256 * 2),
                 WS_VT = al1m(WS_KG + (size_t)3 * MP * 256 * 2), WS_GA = al1m(WS_VT + (size_t)3 * 8192 * 2048 * 2), WS_GB = al1m(WS_GA + (size_t)M * D * 2), WS_BIGEND = al1m(WS_GB + (size_t)M * D * 2),
                 WS_Z = WS_BIG, WS_END = (WS_Z + (size_t)M * FF * 2 > WS_BIGEND) ? al1m(WS_Z + (size_t)M * FF * 2) : WS_BIGEND;

struct Params {
    const float *xp, *xs, *state_pool, *cache0, *cache1, *cache2, *ln1, *w_in, *q_norm, *k_norm, *pool_lin, *pool_scale, *w_pa, *w_pb, *w_o, *ln2, *w_up, *w_down;
    float* out; unsigned char* ws;
};

__device__ __forceinline__ unsigned f2bf(float f) { unsigned u = __builtin_bit_cast(unsigned, f); return (u + 0x7fffu + ((u >> 16) & 1u)) >> 16; }
__device__ __forceinline__ unsigned pk2(float lo, float hi) { return f2bf(lo) | (f2bf(hi) << 16); }
__device__ __forceinline__ float bflo(unsigned w) { return __builtin_bit_cast(float, w << 16); }
__device__ __forceinline__ float bfhi(unsigned w) { return __builtin_bit_cast(float, w & 0xffff0000u); }
__device__ __forceinline__ u32x4 pack8(const f32x4 a, const f32x4 b) { u32x4 w; w.x = cvt_pk_bf16(a[0], a[1]); w.y = cvt_pk_bf16(a[2], a[3]); w.z = cvt_pk_bf16(b[0], b[1]); w.w = cvt_pk_bf16(b[2], b[3]); return w; }
__device__ __forceinline__ void unpack8(const u32x4 w, f32x4& a, f32x4& b) { a = (f32x4){bflo(w.x), bfhi(w.x), bflo(w.y), bfhi(w.y)}; b = (f32x4){bflo(w.z), bfhi(w.z), bflo(w.w), bfhi(w.w)}; }
__device__ __forceinline__ float dot4(const f32x4 a, const f32x4 b) { return (a[0] * b[0] + a[1] * b[1]) + (a[2] * b[2] + a[3] * b[3]); }
__device__ __forceinline__ float wave_sum(float v) {
#pragma unroll
    for (int o = 1; o < 64; o <<= 1) v += __shfl_xor(v, o);
    return v;
}

struct EpiIn {
    static constexpr bool PERM = true, AFTER_DRAIN = false;
    bf16_t *A, *QG, *KG, *VT, *GA, *GB; float* out; const float *qn, *kn;
    __device__ __forceinline__ void operator()(const f32x4 (&acc)[2][2][4][2], const Unit& u, int wr, int wc, int fr, int fq) const {
        const int pn = u.pn; const bool sample = u.pm >= 256;
        const int rbase = u.pm * 256 + wr * 64 + fr;
        if (pn < 2) {
#pragma unroll
            for (int ai = 0; ai < 2; ++ai)
#pragma unroll
                for (int m = 0; m < 4; ++m) { const int row = rbase + ai * 128 + m * 16;
#pragma unroll
                    for (int bj = 0; bj < 2; ++bj) { const int col = pn * 256 + bj * 128 + wc * 32 + fq * 8; const f32x4 v0 = acc[ai][bj][m][0], v1 = acc[ai][bj][m][1];
                        *(u32x4*)(A + (size_t)row * 512 + col) = pack8(v0, v1);
                        if (!sample) { const int b = row >> 11, t = row & 2047; if (t >= 2033) { float* p = out + O_POOLP + (size_t)(b * 15 + t - 2033) * 512 + col; *(f32x4*)p = v0; *(f32x4*)(p + 4) = v1; } }
                        else { const int sr = row - MP, b = sr >> 3, t = sr & 7; float* p = out + O_POOLS + (size_t)(b * 15 + 7 + t) * 512 + col; *(f32x4*)p = v0; *(f32x4*)(p + 4) = v1; } } }
        } else if (pn < 8) {
            const bool isq = pn < 5; const int g = isq ? pn - 2 : pn - 5; const int sh = 2 * g, dil = 1 << sh, L = 2048 >> sh, keep = 128 << sh;
            const float* nw = (isq ? qn : kn) + (g * 4 + wc) * 64 + fq * 8;
            f32x4 w[2][2];
#pragma unroll
            for (int bj = 0; bj < 2; ++bj) { w[bj][0] = *(const f32x4*)(nw + bj * 32); w[bj][1] = *(const f32x4*)(nw + bj * 32 + 4); }
            const size_t okp = g == 0 ? O_KVP0 : (g == 1 ? O_KVP1 : O_KVP2), oks = g == 0 ? O_KVS0 : (g == 1 ? O_KVS1 : O_KVS2);
#pragma unroll
            for (int ai = 0; ai < 2; ++ai)
#pragma unroll
                for (int m = 0; m < 4; ++m) { const int row = rbase + ai * 128 + m * 16;
                    float ss = 0.f;
#pragma unroll
                    for (int bj = 0; bj < 2; ++bj)
#pragma unroll
                        for (int n = 0; n < 2; ++n) ss += dot4(acc[ai][bj][m][n], acc[ai][bj][m][n]);
                    ss += __shfl_xor(ss, 16); ss += __shfl_xor(ss, 32);
                    float rs = __builtin_amdgcn_rsqf(ss * (1.0f / 64.0f) + EPS); if (isq) rs *= QSCALE;
                    int b, t, Rg;
                    if (!sample) { b = row >> 11; t = row & 2047; Rg = b * 524288 + (t & (dil - 1)) * (L * 256) + (t >> sh) * 64 + wc * (L * 64); } else { const int sr = row - MP; b = sr >> 3; t = sr & 7; Rg = row * 256 + wc * 64; }
#pragma unroll
                    for (int bj = 0; bj < 2; ++bj) { const int hc = wc * 64 + bj * 32 + fq * 8, dd = bj * 32 + fq * 8;
                        const f32x4 v0 = acc[ai][bj][m][0] * rs * w[bj][0], v1 = acc[ai][bj][m][1] * rs * w[bj][1];
                        if (isq) { *(u32x4*)(QG + (size_t)g * M * 256 + (size_t)Rg + dd) = pack8(v0, v1); }
                        else {
                            if (!sample) { *(u32x4*)(KG + (size_t)g * MP * 256 + (size_t)Rg + dd) = pack8(v0, v1);
                                if (t >= 2048 - keep) { float* p = out + okp + ((size_t)(b * keep + t - (2048 - keep)) * 2) * 256 + hc; *(f32x4*)p = v0; *(f32x4*)(p + 4) = v1; } }
                            else { float* p = out + oks + ((size_t)(b * keep + keep - 8 + t) * 2) * 256 + hc; *(f32x4*)p = v0; *(f32x4*)(p + 4) = v1; } } } }
        } else if (pn < 11) {
            const int g = pn - 8; const int sh = 2 * g, dil = 1 << sh, L = 2048 >> sh, keep = 128 << sh;
            const size_t okp = g == 0 ? O_KVP0 : (g == 1 ? O_KVP1 : O_KVP2), oks = g == 0 ? O_KVS0 : (g == 1 ? O_KVS1 : O_KVS2);
#pragma unroll
            for (int ai = 0; ai < 2; ++ai)
#pragma unroll
                for (int m = 0; m < 4; ++m) { const int row = rbase + ai * 128 + m * 16;
                    int b, t;
                    if (!sample) { b = row >> 11; t = row & 2047; } else { const int sr = row - MP; b = sr >> 3; t = sr & 7; }
#pragma unroll
                    for (int bj = 0; bj < 2; ++bj) { const int hc = bj * 128 + wc * 32 + fq * 8; const f32x4 v0 = acc[ai][bj][m][0], v1 = acc[ai][bj][m][1];
                        if (!sample) {
                            *(u32x4*)(VT + (size_t)g * MP * 256 + (size_t)b * 524288 + (t & (dil - 1)) * (L * 256) + (hc >> 6) * (L * 64) + (t >> sh) * 64 + (hc & 63)) = pack8(v0, v1);
                            if (t >= 2048 - keep) { float* p = out + okp + ((size_t)(b * keep + t - (2048 - keep)) * 2 + 1) * 256 + hc; *(f32x4*)p = v0; *(f32x4*)(p + 4) = v1; } }
                        else { float* p = out + oks + ((size_t)(b * keep + keep - 8 + t) * 2 + 1) * 256 + hc; *(f32x4*)p = v0; *(f32x4*)(p + 4) = v1; } } }
        } else {
            bf16_t* G = pn < 15 ? GA : GB; const int cb = (pn < 15 ? pn - 11 : pn - 15) * 256 + wc * 32 + fq * 8;
#pragma unroll
            for (int ai = 0; ai < 2; ++ai)
#pragma unroll
                for (int m = 0; m < 4; ++m) { const int row = rbase + ai * 128 + m * 16;
#pragma unroll
                    for (int bj = 0; bj < 2; ++bj) { f32x4 v0 = acc[ai][bj][m][0], v1 = acc[ai][bj][m][1];
#pragma unroll
                        for (int i = 0; i < 4; ++i) { v0[i] = __builtin_amdgcn_rcpf(1.0f + __expf(-v0[i])); v1[i] = __builtin_amdgcn_rcpf(1.0f + __expf(-v1[i])); }
                        *(u32x4*)(G + (size_t)row * 1024 + cb + bj * 128) = pack8(v0, v1); } }
        }
    }
};
template <bool FIRST> struct EpiGate {
    static constexpr bool PERM = true, AFTER_DRAIN = false;
    const bf16_t* G; bf16_t* O;
    __device__ __forceinline__ void operator()(const f32x4 (&acc)[2][2][4][2], const Unit& u, int wr, int wc, int fr, int fq) const {
        const int rbase = u.pm * 256 + wr * 64 + fr, cb = u.pn * 256 + wc * 32 + fq * 8;
#pragma unroll
        for (int ai = 0; ai < 2; ++ai)
#pragma unroll
            for (int m = 0; m < 4; ++m) { const size_t ro = (size_t)(rbase + ai * 128 + m * 16) * 1024 + cb;
#pragma unroll
                for (int bj = 0; bj < 2; ++bj) { f32x4 g0, g1; unpack8(*(const u32x4*)(G + ro + bj * 128), g0, g1);
                    f32x4 v0 = acc[ai][bj][m][0] * g0, v1 = acc[ai][bj][m][1] * g1;
                    if (!FIRST) { f32x4 o0, o1; unpack8(*(const u32x4*)(O + ro + bj * 128), o0, o1); v0 += o0; v1 += o1; }
                    *(u32x4*)(O + ro + bj * 128) = pack8(v0, v1); }
                asm volatile("" ::: "memory"); }
    }
};
struct EpiH {
    static constexpr bool PERM = true, AFTER_DRAIN = false;
    const float *xp, *xs, *ln2; float* y; bf16_t* HN; float* SSP;
    __device__ __forceinline__ void operator()(const f32x4 (&acc)[2][2][4][2], const Unit& u, int wr, int wc, int fr, int fq) const {
        const int rbase = u.pm * 256 + wr * 64 + fr, cb = u.pn * 256 + wc * 32 + fq * 8;
        f32x4 w[2][2];
#pragma unroll
        for (int bj = 0; bj < 2; ++bj) { w[bj][0] = *(const f32x4*)(ln2 + cb + bj * 128); w[bj][1] = *(const f32x4*)(ln2 + cb + bj * 128 + 4); }
#pragma unroll
        for (int ai = 0; ai < 2; ++ai)
#pragma unroll
            for (int m = 0; m < 4; ++m) { const int row = rbase + ai * 128 + m * 16; const float* xr = (row < MP ? xp + (size_t)row * 1024 : xs + (size_t)(row - MP) * 1024) + cb;
                float ss = 0.f;
#pragma unroll
                for (int bj = 0; bj < 2; ++bj) { const f32x4 h0 = *(const f32x4*)(xr + bj * 128) + acc[ai][bj][m][0], h1 = *(const f32x4*)(xr + bj * 128 + 4) + acc[ai][bj][m][1];
                    float* yp = y + (size_t)row * 1024 + cb + bj * 128; *(f32x4*)yp = h0; *(f32x4*)(yp + 4) = h1;
                    ss += dot4(h0, h0) + dot4(h1, h1);
                    *(u32x4*)(HN + (size_t)row * 1024 + cb + bj * 128) = pack8(h0 * w[bj][0], h1 * w[bj][1]); }
                ss += __shfl_xor(ss, 16); ss += __shfl_xor(ss, 32);
                if (fq == 0) SSP[(size_t)row * 16 + u.pn * 4 + wc] = ss;
                asm volatile("" ::: "memory"); }
    }
};
struct EpiUp {
    static constexpr bool PERM = true, AFTER_DRAIN = false;
    const float* SSP; bf16_t* Z;
    __device__ __forceinline__ void operator()(const f32x4 (&acc)[2][2][4][2], const Unit& u, int wr, int wc, int fr, int fq) const {
        const int rbase = u.pm * 256 + wr * 64 + fr, cb = u.pn * 256 + wc * 32 + fq * 8;
#pragma unroll
        for (int ai = 0; ai < 2; ++ai)
#pragma unroll
            for (int m = 0; m < 4; ++m) { const int row = rbase + ai * 128 + m * 16; const f32x4* sp = (const f32x4*)(SSP + (size_t)row * 16);
                const f32x4 s4 = (sp[0] + sp[1]) + (sp[2] + sp[3]); const float rstd = __builtin_amdgcn_rsqf(((s4[0] + s4[1]) + (s4[2] + s4[3])) * (1.0f / 1024.0f) + EPS);
#pragma unroll
                for (int bj = 0; bj < 2; ++bj) { f32x4 v0 = acc[ai][bj][m][0] * rstd, v1 = acc[ai][bj][m][1] * rstd;
#pragma unroll
                    for (int i = 0; i < 4; ++i) { const float a = fmaxf(v0[i], 0.f), b = fmaxf(v1[i], 0.f); v0[i] = a * a; v1[i] = b * b; }
                    *(u32x4*)(Z + (size_t)row * FF + cb + bj * 128) = pack8(v0, v1); }
                asm volatile("" ::: "memory"); }
    }
};
struct EpiDown {
    static constexpr bool PERM = true, AFTER_DRAIN = false;
    float* y;
    __device__ __forceinline__ void operator()(const f32x4 (&acc)[2][2][4][2], const Unit& u, int wr, int wc, int fr, int fq) const {
        const int rbase = u.pm * 256 + wr * 64 + fr, cb = u.pn * 256 + wc * 32 + fq * 8;
#pragma unroll
        for (int ai = 0; ai < 2; ++ai)
#pragma unroll
            for (int m = 0; m < 4; ++m) { float* yr = y + (size_t)(rbase + ai * 128 + m * 16) * 1024 + cb;
#pragma unroll
                for (int bj = 0; bj < 2; ++bj) { float* yp = yr + bj * 128; const f32x4 a = *(const f32x4*)yp + acc[ai][bj][m][0], b = *(const f32x4*)(yp + 4) + acc[ai][bj][m][1]; *(f32x4*)yp = a; *(f32x4*)(yp + 4) = b; }
                asm volatile("" ::: "memory"); }
    }
};
template <bool PERMQK> __device__ __forceinline__ void p0_transpose_item(const float* W, int K, int N, bf16_t* WT, LAS float* scr, int item, int lane) {
    const int nblk = N / 32, kb = item / nblk, nb = item % nblk, k0 = 64 * kb, n0 = 32 * nb;
    int pn0 = n0;
    if (PERMQK) { if (n0 >= 512 && n0 < 2048) { const int tile = n0 >> 8, blk = (n0 >> 5) & 7, wc = blk >> 1, bj = blk & 1; pn0 = tile * 256 + bj * 128 + wc * 32; } }
#pragma unroll
    for (int i = 0; i < 32; ++i) { const int kk = 2 * i + (lane >> 5); scr[kk * 33 + (lane & 31)] = W[(size_t)(k0 + kk) * N + n0 + (lane & 31)]; }
    asm volatile("s_waitcnt lgkmcnt(0)" ::: "memory");
    const int c = lane & 7;
#pragma unroll
    for (int j = 0; j < 4; ++j) { const int n = (lane >> 3) + 8 * j; const LAS float* s = scr + (8 * c) * 33 + n;
        u32x4 o; o.x = pk2(s[0 * 33], s[1 * 33]); o.y = pk2(s[2 * 33], s[3 * 33]); o.z = pk2(s[4 * 33], s[5 * 33]); o.w = pk2(s[6 * 33], s[7 * 33]);
        *(u32x4*)(WT + (size_t)(pn0 + n) * K + k0 + 8 * c) = o; }
    asm volatile("s_waitcnt lgkmcnt(0)" ::: "memory");
}

__device__ __forceinline__ void p0_prologue(const Params& P, LAS unsigned char* lds, int gw, int NGW, int gtid, int NGT, int wave, int lane) {
    unsigned char* ws = P.ws;
    LAS float* scr = (LAS float*)(lds + wave * 16384);
    constexpr int I_IN = (D / 64) * (NIN / 32), I_PB = (256 / 64) * (D / 32), I_O = (D / 64) * (D / 32), I_UP = (D / 64) * (FF / 32), I_DN = (FF / 64) * (D / 32);
    constexpr int NITEMS = I_IN + I_PB + I_O + I_UP + I_DN;
    for (int it = gw; it < NITEMS; it += NGW) {
        int r = it;
        if (r < I_IN) { p0_transpose_item<true>(P.w_in, D, NIN, (bf16_t*)(ws + WS_WIN), scr, r, lane); continue; } r -= I_IN;
        if (r < I_PB) { p0_transpose_item<false>(P.w_pb, 256, D, (bf16_t*)(ws + WS_WPB), scr, r, lane); continue; } r -= I_PB;
        if (r < I_O) { p0_transpose_item<false>(P.w_o, D, D, (bf16_t*)(ws + WS_WO), scr, r, lane); continue; } r -= I_O;
        if (r < I_UP) { p0_transpose_item<false>(P.w_up, D, FF, (bf16_t*)(ws + WS_WUP), scr, r, lane); continue; } r -= I_UP;
        p0_transpose_item<false>(P.w_down, FF, D, (bf16_t*)(ws + WS_WDN), scr, r, lane);
    }
    {
        bf16_t* WE = (bf16_t*)(ws + WS_WEFF);
        for (int wi = gw; wi < 1024; wi += NGW) {
            const int ch = __builtin_amdgcn_readfirstlane(wi >> 4), d = (wi & 15) * 64 + lane, g = ch >> 4, c0 = (ch & 15) * 8;
            float a[8];
#pragma unroll
            for (int i = 0; i < 8; ++i) a[i] = 0.f;
            const float* lin = P.pool_lin + (size_t)(g * 128 + c0) * 128; const float* wp = P.w_pa + (size_t)(g * 128) * 1024 + d; const float* sc = P.pool_scale + g * 128;
#pragma unroll 16
            for (int e = 0; e < 128; ++e) { const float wv = wp[(size_t)e * 1024] * sc[e];
#pragma unroll
                for (int i = 0; i < 8; ++i) a[i] += lin[i * 128 + e] * wv; }
            u32x4 o; o.x = pk2(a[0], a[1]); o.y = pk2(a[2], a[3]); o.z = pk2(a[4], a[5]); o.w = pk2(a[6], a[7]);
            *(u32x4*)(WE + (size_t)d * 512 + g * 128 + c0) = o;
        }
    }
    {
        bf16_t* U = (bf16_t*)(ws + WS_U);
        f32x4 lw[4];
#pragma unroll
        for (int j = 0; j < 4; ++j) lw[j] = ((const f32x4*)P.ln1)[lane + 64 * j];
        for (int m0 = gw * 4; m0 < M; m0 += NGW * 4) {
            f32x4 v[4][4];
#pragma unroll
            for (int rr = 0; rr < 4; ++rr) { const int m = m0 + rr; const f32x4* xr = (const f32x4*)(m < MP ? P.xp + (size_t)m * D : P.xs + (size_t)(m - MP) * D) + lane;
#pragma unroll
                for (int j = 0; j < 4; ++j) v[rr][j] = __builtin_nontemporal_load(xr + 64 * j); }
#pragma unroll
            for (int rr = 0; rr < 4; ++rr) { float sq = 0.f;
#pragma unroll
                for (int j = 0; j < 4; ++j) sq += dot4(v[rr][j], v[rr][j]);
                const float rstd = __builtin_amdgcn_rsqf(wave_sum(sq) * (1.f / D) + EPS);
                u32x2* o8 = (u32x2*)(U + (size_t)(m0 + rr) * D) + lane;
#pragma unroll
                for (int j = 0; j < 4; ++j) { const f32x4 y = v[rr][j] * rstd * lw[j]; u32x2 o; o.x = cvt_pk_bf16(y[0], y[1]); o.y = cvt_pk_bf16(y[2], y[3]); o8[64 * j] = o; } }
        }
    }
}
constexpr int CW_COPY = 3584, CW_DONE = 3648;
constexpr int CH4 = 4096;
constexpr int NCH0 = SB * 120 * 128 / CH4, NCH1 = SB * 504 * 128 / CH4, NCH2 = SB * 2040 * 128 / CH4, NCHUNK = NCH0 + NCH1 + NCH2;
static_assert(NCHUNK % 2 == 0, "chunks are claimed in pairs");
template <int G_> __device__ __forceinline__ void copy_chunk_g(const Params& P, int cl, int tid) {
    constexpr int Lw = 128 << (2 * G_), per_b = (Lw - 8) * 128;
    const f32x4* src = (const f32x4*)(G_ == 0 ? P.cache0 : (G_ == 1 ? P.cache1 : P.cache2)); f32x4* dst = (f32x4*)(P.out + o_kvs(G_));
    f32x4 v[8]; unsigned di[8];
#pragma unroll
    for (int k = 0; k < 8; ++k) { const unsigned f = (unsigned)cl * CH4 + tid + 512 * k, b = f / (unsigned)per_b, rem = f - b * per_b; di[k] = b * (Lw * 128) + rem; v[k] = __builtin_nontemporal_load(src + di[k] + 1024); }
#pragma unroll
    for (int k = 0; k < 8; ++k) __builtin_nontemporal_store(v[k], dst + di[k]);
}
__device__ __forceinline__ void copy_chunk(const Params& P, int c, int tid) {
    if (c < NCH0) copy_chunk_g<0>(P, c, tid); else if (c < NCH0 + NCH1) copy_chunk_g<1>(P, c - NCH0, tid); else copy_chunk_g<2>(P, c - NCH0 - NCH1, tid);
}
__device__ __forceinline__ void copy_fill(const Params& P, volatile LAS unsigned* MISC, int w, int tid, int G) {
    unsigned* ctl = (unsigned*)P.ws;
    __syncthreads();
    if (tid == 0) __hip_atomic_fetch_add(ctl + CW_DONE + 64 * w, 1u, __ATOMIC_RELAXED, __HIP_MEMORY_SCOPE_AGENT);
    for (;;) {
        if (tid == 0) { int c = -1;
            if (__hip_atomic_load(ctl + CW_DONE + 64 * w, __ATOMIC_RELAXED, __HIP_MEMORY_SCOPE_AGENT) < (unsigned)G) { const unsigned n = __hip_atomic_fetch_add(ctl + CW_COPY, 1u, __ATOMIC_RELAXED, __HIP_MEMORY_SCOPE_AGENT); if (n < (unsigned)NCHUNK) c = (int)n; }
            MISC[16] = (unsigned)c; }
        __syncthreads();
        const int c = (int)MISC[16];
        __syncthreads();
        if (c < 0) break;
        copy_chunk(P, c, tid);
    }
}
__device__ __forceinline__ void copy_rest(const Params& P, volatile LAS unsigned* MISC, int tid) {
    unsigned* ctl = (unsigned*)P.ws;
    for (;;) {
        if (tid == 0) { const unsigned n = __hip_atomic_fetch_add(ctl + CW_COPY, 2u, __ATOMIC_RELAXED, __HIP_MEMORY_SCOPE_AGENT); MISC[16] = n + 1 < (unsigned)NCHUNK ? n : 0xffffffffu; }
        __syncthreads();
        const int c = (int)MISC[16];
        __syncthreads();
        if (c < 0) break;
        copy_chunk(P, c, tid); copy_chunk(P, c + 1, tid);
    }
}
__device__ __forceinline__ void chunk_ptrs(const Params& P, int c, int k, int tid, const f32x4*& src, f32x4*& dst) {
    if (c < NCH0) { const unsigned f = (unsigned)c * CH4 + tid + 512 * k, b = f / 15360u, off = b * (128 * 128) + (f - b * 15360u); src = (const f32x4*)P.cache0 + off + 1024; dst = (f32x4*)(P.out + O_KVS0) + off; }
    else if (c < NCH0 + NCH1) { const unsigned f = (unsigned)(c - NCH0) * CH4 + tid + 512 * k, b = f / 64512u, off = b * (512 * 128) + (f - b * 64512u); src = (const f32x4*)P.cache1 + off + 1024; dst = (f32x4*)(P.out + O_KVS1) + off; }
    else { const unsigned f = (unsigned)(c - NCH0 - NCH1) * CH4 + tid + 512 * k, b = f / 261120u, off = b * (2048 * 128) + (f - b * 261120u); src = (const f32x4*)P.cache2 + off + 1024; dst = (f32x4*)(P.out + O_KVS2) + off; }
}
__device__ __forceinline__ void copy_beside(const Params& P, volatile LAS unsigned* MISC, int tid, unsigned nwork) {
    unsigned* ctl = (unsigned*)P.ws;
    for (;;) {
        if (tid == 0) { int c = -1;
            if (__hip_atomic_load(ctl + CW_DONE, __ATOMIC_RELAXED, __HIP_MEMORY_SCOPE_AGENT) < nwork) { const unsigned n = __hip_atomic_fetch_add(ctl + CW_COPY, 2u, __ATOMIC_RELAXED, __HIP_MEMORY_SCOPE_AGENT); if (n + 1 < (unsigned)NCHUNK) c = (int)n; }
            MISC[16] = (unsigned)c; }
        __syncthreads();
        const int c = (int)MISC[16];
        __syncthreads();
        if (c < 0) break;
        f32x4 v[16];
#pragma unroll
        for (int j = 0; j < 2; ++j)
#pragma unroll
            for (int k = 0; k < 8; ++k) { const f32x4* src; f32x4* dst; chunk_ptrs(P, c + j, k, tid, src, dst); v[j * 8 + k] = __builtin_nontemporal_load(src); }
#pragma unroll
        for (int j = 0; j < 2; ++j)
#pragma unroll
            for (int k = 0; k < 8; ++k) { const f32x4* src; f32x4* dst; chunk_ptrs(P, c + j, k, tid, src, dst); __builtin_nontemporal_store(v[j * 8 + k], dst); }
    }
}
__device__ __forceinline__ void copy_pool_state(const Params& P, int gtid, int NGT) {
    const f32x4* src = (const f32x4*)P.state_pool; f32x4* dst = (f32x4*)(P.out + O_POOLS);
    for (int i = gtid; i < SB * 7 * 128; i += NGT) { const int b = i / (7 * 128), rem = i - b * 7 * 128; dst[(size_t)b * 15 * 128 + rem] = src[(size_t)b * 15 * 128 + 8 * 128 + rem]; }
}
template <int W> __device__ __forceinline__ void pool_diff_item(const Params& P, int rq, int gidx, int lane) {
    const bf16_t* A = (const bf16_t*)(P.ws + WS_A); bf16_t* DF = (bf16_t*)(P.ws + WS_DIFF);
    const int row = rq * 4 + (lane >> 4), c0 = gidx * 128 + (lane & 15) * 8;
    f32x4 s0 = {0.f, 0.f, 0.f, 0.f}, s1 = {0.f, 0.f, 0.f, 0.f}, a0, a1; float inv;
    if (row < MP) { const int t = row & 2047; const int cnt = (t + 1 < W) ? t + 1 : W; inv = 1.0f / (float)cnt;
        u32x4 x[W];
#pragma unroll
        for (int j = 0; j < W; ++j) x[j] = *(const u32x4*)(A + (size_t)(row - (j <= t ? j : 0)) * 512 + c0);
        unpack8(x[0], a0, a1);
#pragma unroll
        for (int j = 0; j < W; ++j) { f32x4 y0, y1; unpack8(x[j], y0, y1); if (j <= t) { s0 += y0; s1 += y1; } } }
    else { const int sr = row - MP, b = sr >> 3, t = sr & 7; inv = 1.0f / (float)W;
        unpack8(*(const u32x4*)(A + (size_t)row * 512 + c0), a0, a1);
#pragma unroll
        for (int j = 0; j < W; ++j) { const int tt = t - j; f32x4 x0, x1;
            if (tt >= 0) unpack8(*(const u32x4*)(A + (size_t)(row - j) * 512 + c0), x0, x1);
            else { const float* sp = P.state_pool + (size_t)(b * 15 + 15 + tt) * 512 + c0; x0 = *(const f32x4*)sp; x1 = *(const f32x4*)(sp + 4); }
            s0 += x0; s1 += x1; } }
    *(u32x4*)(DF + (size_t)row * 512 + c0) = pack8(s0 * inv - a0, s1 * inv - a1);
}
template <int W> __device__ __forceinline__ void pool_diff_block(const Params& P, int blk, int gidx, int lane) {
    const bf16_t* A = (const bf16_t*)(P.ws + WS_A); bf16_t* DF = (bf16_t*)(P.ws + WS_DIFF);
    const int row0 = blk * 64 + (lane >> 4) * 16, t0 = row0 & 2047, c0 = gidx * 128 + (lane & 15) * 8;
    const bf16_t* ap = A + (size_t)row0 * 512 + c0;
    u32x4 x[16 + W - 1];
#pragma unroll
    for (int k = 0; k < 16 + W - 1; ++k) { const int dt = k - (W - 1); x[k] = (t0 + dt >= 0) ? *(const u32x4*)(ap + dt * 512) : (u32x4){0u, 0u, 0u, 0u}; }
    f32x4 s0 = {0.f, 0.f, 0.f, 0.f}, s1 = {0.f, 0.f, 0.f, 0.f};
#pragma unroll
    for (int k = 0; k < W - 1; ++k) { f32x4 y0, y1; unpack8(x[k], y0, y1); s0 += y0; s1 += y1; }
#pragma unroll
    for (int i = 0; i < 16; ++i) { f32x4 a0, a1, z0, z1; unpack8(x[W - 1 + i], a0, a1); s0 += a0; s1 += a1;
        const int t = t0 + i; const float inv = 1.0f / (float)((t + 1 < W) ? t + 1 : W);
        *(u32x4*)(DF + (size_t)(row0 + i) * 512 + c0) = pack8(s0 * inv - a0, s1 * inv - a1);
        unpack8(x[i], z0, z1); s0 -= z0; s1 -= z1; }
}
__device__ __forceinline__ void pool_diff(const Params& P, int gw, int NGW, int lane) {
    for (int wi = gw; wi < (MP / 64) * 4; wi += NGW) { const int blk = wi >> 2, gidx = wi & 3;
        if (gidx == 0) pool_diff_block<2>(P, blk, 0, lane); else if (gidx == 1) pool_diff_block<4>(P, blk, 1, lane); else if (gidx == 2) pool_diff_block<8>(P, blk, 2, lane); else pool_diff_block<16>(P, blk, 3, lane); }
    for (int wi = gw; wi < MS; wi += NGW) { const int rq = (MP >> 2) + (wi >> 2), gidx = wi & 3;
        if (gidx == 0) pool_diff_item<2>(P, rq, 0, lane); else if (gidx == 1) pool_diff_item<4>(P, rq, 1, lane); else if (gidx == 2) pool_diff_item<8>(P, rq, 2, lane); else pool_diff_item<16>(P, rq, 3, lane); }
}
typedef short s16x4 __attribute__((ext_vector_type(4)));
__device__ __forceinline__ s16x4 vtr(const LAS unsigned char* p) { return __builtin_bit_cast(s16x4, __builtin_amdgcn_ds_read_tr16_b64_v4i16((LAS s16x4*)p)); }
__device__ __forceinline__ void attn_prompt_unit(const Params& P, LAS unsigned char* vl, int u, int lane) {
    const int g = u >> 13; int rem = u & 8191; const int b = rem >> 8; rem &= 255; const int h = rem >> 6; const int idx = rem & 63;
    const int sh = 2 * g, L = 2048 >> sh, tsh = 6 - sh;
    const int r = idx >> tsh, qt = idx & ((1 << tsh) - 1), mq0 = qt * 32;
    const int ql = lane & 15, q = lane >> 4;
    const size_t hb = (size_t)b * 524288 + (size_t)r * (L * 256) + (size_t)h * (L * 64);
    const bf16_t* Qb = (const bf16_t*)(P.ws + WS_QG) + (size_t)g * M * 256 + hb; const bf16_t* Kb = (const bf16_t*)(P.ws + WS_KG) + (size_t)g * MP * 256 + hb; const bf16_t* Vb = (const bf16_t*)(P.ws + WS_VT) + (size_t)g * MP * 256 + hb;
    const float NEG = -1e30f;
    bf16x8 qf[2][2];
#pragma unroll
    for (int a = 0; a < 2; ++a) { const bf16_t* qp = Qb + (mq0 + 16 * a + ql) * 64 + 8 * q; qf[a][0] = *(const bf16x8*)qp; qf[a][1] = *(const bf16x8*)(qp + 32); }
    const int krow = 8 * (ql >> 2) + (ql & 3);
    f32x4 s[2][5][2];
#pragma unroll
    for (int c = 0; c < 5; ++c) { const int kc0 = mq0 - 128 + 32 * c;
        if (kc0 >= 0) {
            bf16x8 kf[2][2];
#pragma unroll
            for (int tt = 0; tt < 2; ++tt) { const bf16_t* kp = Kb + (kc0 + krow + 4 * tt) * 64 + 8 * q; kf[tt][0] = *(const bf16x8*)kp; kf[tt][1] = *(const bf16x8*)(kp + 32); }
#pragma unroll
            for (int a = 0; a < 2; ++a)
#pragma unroll
                for (int tt = 0; tt < 2; ++tt) { f32x4 x = {0.f, 0.f, 0.f, 0.f}; x = __builtin_amdgcn_mfma_f32_16x16x32_bf16(kf[tt][0], qf[a][0], x, 0, 0, 0); x = __builtin_amdgcn_mfma_f32_16x16x32_bf16(kf[tt][1], qf[a][1], x, 0, 0, 0);
                    const int d0 = (mq0 + 16 * a + ql) - (kc0 + 8 * q + 4 * tt);
#pragma unroll
                    for (int i = 0; i < 4; ++i) if ((unsigned)(d0 - i) > 128u) x[i] = NEG;
                    s[a][c][tt] = x; }
        } else {
#pragma unroll
            for (int a = 0; a < 2; ++a) { s[a][c][0] = (f32x4){NEG, NEG, NEG, NEG}; s[a][c][1] = s[a][c][0]; }
        } }
    u32x4 vr[5][4];
#pragma unroll
    for (int c = 0; c < 4; ++c) { const int kc0 = mq0 - 128 + 32 * c;
        if (kc0 >= 0) {
#pragma unroll
            for (int k = 0; k < 4; ++k) { const int p = lane + 64 * k; vr[c][k] = *(const u32x4*)(Vb + (kc0 + (p >> 3)) * 64 + (p & 7) * 8); } } }
    float mx[2], l[2];
#pragma unroll
    for (int a = 0; a < 2; ++a) { float m_ = NEG;
#pragma unroll
        for (int c = 0; c < 5; ++c)
#pragma unroll
            for (int tt = 0; tt < 2; ++tt) m_ = fmaxf(m_, fmaxf(fmaxf(s[a][c][tt][0], s[a][c][tt][1]), fmaxf(s[a][c][tt][2], s[a][c][tt][3])));
        m_ = fmaxf(m_, __shfl_xor(m_, 16)); m_ = fmaxf(m_, __shfl_xor(m_, 32));
        float l_ = 0.f;
#pragma unroll
        for (int c = 0; c < 5; ++c)
#pragma unroll
            for (int tt = 0; tt < 2; ++tt)
#pragma unroll
                for (int i = 0; i < 4; ++i) { const float p = __builtin_amdgcn_exp2f(s[a][c][tt][i] - m_); s[a][c][tt][i] = p; l_ += p; }
        l_ += __shfl_xor(l_, 16); l_ += __shfl_xor(l_, 32);
        mx[a] = m_; l[a] = l_; }
    f32x4 o[2][4];
#pragma unroll
    for (int a = 0; a < 2; ++a)
#pragma unroll
        for (int dt = 0; dt < 4; ++dt) o[a][dt] = (f32x4){0.f, 0.f, 0.f, 0.f};
#pragma unroll
    for (int c = 0; c < 5; ++c) { const int kc0 = mq0 - 128 + 32 * c;
        if (c == 1) {
#pragma unroll
            for (int k = 0; k < 4; ++k) { const int p = lane + 64 * k; vr[4][k] = *(const u32x4*)(Vb + (mq0 + (p >> 3)) * 64 + (p & 7) * 8); } }
        if (kc0 >= 0) {
            asm volatile("" ::: "memory");
#pragma unroll
            for (int k = 0; k < 4; ++k) { const int p = lane + 64 * k; *(LAS u32x4*)(vl + (p >> 3) * 144 + (p & 7) * 16) = vr[c][k]; }
            asm volatile("s_waitcnt lgkmcnt(0)" ::: "memory");
            bf16x8 pb[2];
#pragma unroll
            for (int a = 0; a < 2; ++a) { u32x4 pw; pw.x = cvt_pk_bf16(s[a][c][0][0], s[a][c][0][1]); pw.y = cvt_pk_bf16(s[a][c][0][2], s[a][c][0][3]); pw.z = cvt_pk_bf16(s[a][c][1][0], s[a][c][1][1]); pw.w = cvt_pk_bf16(s[a][c][1][2], s[a][c][1][3]); pb[a] = __builtin_bit_cast(bf16x8, pw); }
#pragma unroll
            for (int dt = 0; dt < 4; ++dt) { const LAS unsigned char* tp = vl + (8 * q + (ql >> 2)) * 144 + (16 * dt + 4 * (ql & 3)) * 2;
                const s16x4 t0 = vtr(tp), t1 = vtr(tp + 4 * 144);
                const bf16x8 vf = {t0[0], t0[1], t0[2], t0[3], t1[0], t1[1], t1[2], t1[3]};
#pragma unroll
                for (int a = 0; a < 2; ++a) o[a][dt] = __builtin_amdgcn_mfma_f32_16x16x32_bf16(vf, pb[a], o[a][dt], 0, 0, 0); }
            asm volatile("s_waitcnt lgkmcnt(0)" ::: "memory");
        } }
#pragma unroll
    for (int a = 0; a < 2; ++a) { const float il = 1.0f / l[a];
        const int tok = b * 2048 + (mq0 + 16 * a + ql) * (1 << sh) + r;
        bf16_t* og = (bf16_t*)(P.ws + WS_OG) + ((size_t)g * MP + tok) * 256 + h * 64 + 4 * q;
#pragma unroll
        for (int dt = 0; dt < 4; ++dt) { u32x2 w; w.x = cvt_pk_bf16(o[a][dt][0] * il, o[a][dt][1] * il); w.y = cvt_pk_bf16(o[a][dt][2] * il, o[a][dt][3] * il); *(u32x2*)(og + dt * 16) = w; }
        if (q == 0) ((float*)(P.ws + WS_LSE))[((size_t)g * MP + tok) * 4 + h] = mx[a] + __builtin_amdgcn_logf(l[a]); }
}
__device__ __forceinline__ void attn_sample_item(const Params& P, int it, int lane) {
    const int b = it >> 5, t = (it >> 2) & 7, h = it & 3, kg = lane >> 4, dl = lane & 15;
    float m = -1e30f, l = 0.f; f32x4 acc = {0.f, 0.f, 0.f, 0.f};
#pragma unroll 1
    for (int g = 0; g < 3; ++g) {
        const int sh = 2 * g, dil = 1 << sh, Lw = 128 << sh;
        const u32x2 qw = *(const u32x2*)((const bf16_t*)(P.ws + WS_QG) + (size_t)g * M * 256 + (size_t)(MP + b * 8 + t) * 256 + h * 64 + 4 * dl);
        const f32x4 q4 = {bflo(qw.x), bfhi(qw.x), bflo(qw.y), bfhi(qw.y)};
        const float* cache = (g == 0 ? P.cache0 : (g == 1 ? P.cache1 : P.cache2)) + (size_t)b * Lw * 512; const float* newr = P.out + o_kvs(g) + (size_t)b * Lw * 512;
#pragma unroll 1
        for (int bt = 0; bt < 3; ++bt) {
            asm volatile("" ::: "memory");
            f32x4 k4[11], v4[11];
#pragma unroll
            for (int u = 0; u < 11; ++u) { const int j = 4 * (bt * 11 + u) + kg; const int jj = j <= 128 ? j : 128; const int idx = Lw + t - jj * dil;
                const float* rowp = (idx < Lw ? cache + (size_t)idx * 512 : newr + (size_t)(idx - 8) * 512) + h * 64 + 4 * dl;
                k4[u] = *(const f32x4*)rowp; v4[u] = *(const f32x4*)(rowp + 256); }
#pragma unroll
            for (int u = 0; u < 11; ++u) { const int j = 4 * (bt * 11 + u) + kg;
                float s = dot4(q4, k4[u]); s += __shfl_xor(s, 1); s += __shfl_xor(s, 2); s += __shfl_xor(s, 4); s += __shfl_xor(s, 8);
                if (j > 128) s = -1e30f;
                const float mn = fmaxf(m, s), al = __builtin_amdgcn_exp2f(m - mn), p = __builtin_amdgcn_exp2f(s - mn);
                l = l * al + p; acc = acc * al + v4[u] * p; m = mn; }
        }
    }
    float mm = fmaxf(m, __shfl_xor(m, 16)); mm = fmaxf(mm, __shfl_xor(mm, 32));
    const float f = __builtin_amdgcn_exp2f(m - mm); l *= f; acc = acc * f;
    l += __shfl_xor(l, 16); l += __shfl_xor(l, 32);
#pragma unroll
    for (int i = 0; i < 4; ++i) { acc[i] += __shfl_xor(acc[i], 16); acc[i] += __shfl_xor(acc[i], 32); }
    if (kg == 0) { const float il = 1.0f / l; u32x2 w; w.x = cvt_pk_bf16(acc[0] * il, acc[1] * il); w.y = cvt_pk_bf16(acc[2] * il, acc[3] * il);
        *(u32x2*)((bf16_t*)(P.ws + WS_ATTN) + (size_t)(MP + b * 8 + t) * 256 + h * 64 + 4 * dl) = w; }
}
__device__ __forceinline__ void attn_combine(const Params& P, int gtid, int NGT) {
    const bf16_t* OG = (const bf16_t*)(P.ws + WS_OG); const float* LSE = (const float*)(P.ws + WS_LSE); bf16_t* AT = (bf16_t*)(P.ws + WS_ATTN);
    for (int it = gtid; it < MP * 32; it += NGT) { const int row = it >> 5, c8 = it & 31, h = c8 >> 3;
        const float l0 = LSE[((size_t)0 * MP + row) * 4 + h], l1 = LSE[((size_t)1 * MP + row) * 4 + h], l2 = LSE[((size_t)2 * MP + row) * 4 + h];
        const float mx = fmaxf(l0, fmaxf(l1, l2)); float w0 = __builtin_amdgcn_exp2f(l0 - mx), w1 = __builtin_amdgcn_exp2f(l1 - mx), w2 = __builtin_amdgcn_exp2f(l2 - mx);
        const float inv = 1.0f / (w0 + w1 + w2); w0 *= inv; w1 *= inv; w2 *= inv;
        f32x4 a0, a1, b0, b1, c0, c1;
        unpack8(*(const u32x4*)(OG + ((size_t)0 * MP + row) * 256 + c8 * 8), a0, a1); unpack8(*(const u32x4*)(OG + ((size_t)1 * MP + row) * 256 + c8 * 8), b0, b1); unpack8(*(const u32x4*)(OG + ((size_t)2 * MP + row) * 256 + c8 * 8), c0, c1);
        *(u32x4*)(AT + (size_t)row * 256 + c8 * 8) = pack8(a0 * w0 + b0 * w1 + c0 * w2, a1 * w0 + b1 * w1 + c1 * w2); }
}

#define XB_TMO      128
#define XB_XCNT(j)  (256  + 64 * (j))
#define XB_XSUB(j)  (1280 + 64 * (j))
#define XB_XGEN(j)  (2304 + 64 * (j))
#define XB_TOP      3328
#define XB_TOPGEN   3392
#define XCD_BAR_WORDS 3456
#define XB_SPIN_CAP (1u << 18)

__device__ __forceinline__ unsigned xb_ld(unsigned* p)              { return __hip_atomic_load(p, __ATOMIC_RELAXED, __HIP_MEMORY_SCOPE_AGENT); }
__device__ __forceinline__ unsigned xb_add(unsigned* p, unsigned v) { return __hip_atomic_fetch_add(p, v, __ATOMIC_RELAXED, __HIP_MEMORY_SCOPE_AGENT); }
__device__ __forceinline__ unsigned xb_xcc_id() { return (unsigned)__builtin_amdgcn_s_getreg((3 << 11) | 20) & 0xFu; }
#define XB_SPIN(cond, bar) do { unsigned _sp = 0; while (cond) { __builtin_amdgcn_s_sleep(1); \
    if ((++_sp & 255u) == 0u) { if (xb_ld(&(bar)[XB_TMO])) break; if (_sp > XB_SPIN_CAP) { atomicAdd(&(bar)[XB_TMO], 1u); break; } } } } while (0)

struct XcdBarrier {
    unsigned* bar; unsigned x;
    volatile LAS unsigned* st;
};

__device__ __forceinline__ XcdBarrier xcd_barrier_post(unsigned* bar, volatile LAS unsigned* st) {
    XcdBarrier b; b.bar = bar; b.x = xb_xcc_id(); b.st = st;
    if (threadIdx.x == 0) (void)xb_add(&bar[XB_XCNT(b.x)], 1u);
    return b;
}
__device__ __forceinline__ void xcd_barrier_complete(unsigned* bar, unsigned x, unsigned& nloc, unsigned& nx) {
    const unsigned G = gridDim.x * gridDim.y * gridDim.z;
    unsigned sum, cnt, mine, sp = 0u;
    for (;;) {
        sum = 0u; cnt = 0u; mine = 0u;
#pragma unroll
        for (unsigned j = 0; j < 16; ++j) { const unsigned c = xb_ld(&bar[XB_XCNT(j)]); sum += c; cnt += (c > 0u) ? 1u : 0u; mine = (j == x) ? c : mine; }
        if (sum == G) break;
        __builtin_amdgcn_s_sleep(1);
        if ((++sp & 255u) == 0u) { if (xb_ld(&bar[XB_TMO])) break; if (sp > XB_SPIN_CAP) { atomicAdd(&bar[XB_TMO], 1u); break; } }
    }
    nloc = mine > 0u ? mine : 1u; nx = cnt > 0u ? cnt : 1u;
}

__device__ __forceinline__ void xcd_barrier(const XcdBarrier& b) {
    asm volatile("s_waitcnt vmcnt(0)" ::: "memory");
    __syncthreads();
    if (threadIdx.x == 0) {
        unsigned* bar = b.bar;
        __builtin_amdgcn_s_waitcnt(0);
        unsigned nloc = b.st[0], nx = b.st[1];
        if (nloc == 0u) { xcd_barrier_complete(bar, b.x, nloc, nx); b.st[0] = nloc; b.st[1] = nx; }
        const unsigned old = xb_add(&bar[XB_XSUB(b.x)], 1u);
        const unsigned gen = old / nloc;
        if (old + 1u == (gen + 1u) * nloc) {
            __builtin_amdgcn_fence(__ATOMIC_RELEASE, "agent");
            asm volatile("s_waitcnt vmcnt(0)" ::: "memory");
            const unsigned og = xb_add(&bar[XB_TOP], 1u);
            const unsigned tg = og / nx;
            if (og + 1u == (tg + 1u) * nx) xb_add(&bar[XB_TOPGEN], 1u);
            else XB_SPIN(xb_ld(&bar[XB_TOPGEN]) == tg, bar);
            __builtin_amdgcn_fence(__ATOMIC_ACQUIRE, "agent");
            xb_add(&bar[XB_XGEN(b.x)], 1u);
            asm volatile("s_waitcnt vmcnt(0)" ::: "memory");
        } else {
            XB_SPIN(xb_ld(&bar[XB_XGEN(b.x)]) == gen, bar);
            __builtin_amdgcn_fence(__ATOMIC_ACQUIRE, "agent");
            asm volatile("s_waitcnt vmcnt(0)" ::: "memory");
        }
    }
    __syncthreads();
}

constexpr int LDS_BYTES = 131072 + 1024;
__global__ void __launch_bounds__(512, 2) fwd_megakernel(Params P) {
    extern __shared__ __attribute__((aligned(16))) unsigned char lds_raw[];
    LAS unsigned char* lds = (LAS unsigned char*)lds_raw;
    const int tid = threadIdx.x, lane = tid & 63, wave = __builtin_amdgcn_readfirstlane(tid >> 6);
    volatile LAS unsigned* MISC = (volatile LAS unsigned*)(lds + 131072);
    if (tid < 64) MISC[tid] = 0u;
    __syncthreads();
    if (P.ws == nullptr) cg::this_grid().sync();
    XcdBarrier xbar = xcd_barrier_post((unsigned*)P.ws, MISC + 8);
    const int G = gridDim.x, bx = blockIdx.x;
    const int gw = bx * 8 + wave, NGW = G * 8, gtid = bx * 512 + tid, NGT = G * 512;
    unsigned char* ws = P.ws;
    p0_prologue(P, lds, gw, NGW, gtid, NGT, wave, lane);
    copy_pool_state(P, gtid, NGT);
    xcd_barrier(xbar);
    { pg8::Gemm g{(const bf16_t*)(ws + WS_U), (const bf16_t*)(ws + WS_WIN), M, NIN, D}; pg8::StaticOrder S; S.init(M, NIN, G, bx);
      EpiIn E{(bf16_t*)(ws + WS_A), (bf16_t*)(ws + WS_QG), (bf16_t*)(ws + WS_KG), (bf16_t*)(ws + WS_VT), (bf16_t*)(ws + WS_GA), (bf16_t*)(ws + WS_GB), P.out, P.q_norm, P.k_norm};
      pg8::gemm_phase<EpiIn, pg8::StaticOrder, true, true>(lds, g, S, E); }
    xcd_barrier(xbar);
    {
        const int npu = (3 * 8192 - gw + NGW - 1) / NGW, nsi = gw < 4096 ? (4096 - gw + NGW - 1) / NGW : 0, first_s = (bx & 1) ? 0 : npu;
#pragma unroll 1
        for (int i = 0; i < npu + nsi; ++i) {
            if (i >= first_s && i < first_s + nsi) attn_sample_item(P, gw + (i - first_s) * NGW, lane);
            else attn_prompt_unit(P, lds + wave * 4608, gw + (i < first_s ? i : i - nsi) * NGW, lane);
        }
    }
    pool_diff(P, gw, NGW, lane);
    xcd_barrier(xbar);
    { pg8::Gemm g{(const bf16_t*)(ws + WS_DIFF), (const bf16_t*)(ws + WS_WEFF), M, D, 512}; pg8::StaticOrder S; S.init(M, D, G, bx);
      EpiGate<true> E{(const bf16_t*)(ws + WS_GA), (bf16_t*)(ws + WS_MIX)};
      pg8::gemm_phase<EpiGate<true>, pg8::StaticOrder, true, true>(lds, g, S, E); }
    attn_combine(P, gtid, NGT);
    xcd_barrier(xbar);
    { pg8::Gemm g{(const bf16_t*)(ws + WS_ATTN), (const bf16_t*)(ws + WS_WPB), M, D, 256}; pg8::StaticOrder S; S.init(M, D, G, bx);
      EpiGate<false> E{(const bf16_t*)(ws + WS_GB), (bf16_t*)(ws + WS_MIX)};
      pg8::gemm_phase<EpiGate<false>, pg8::StaticOrder, true, true>(lds, g, S, E); }
    xcd_barrier(xbar);
    { pg8::Gemm g{(const bf16_t*)(ws + WS_MIX), (const bf16_t*)(ws + WS_WO), M, D, D}; pg8::StaticOrder S; S.init(M, D, G, bx);
      EpiH E{P.xp, P.xs, P.ln2, P.out + O_Y, (bf16_t*)(ws + WS_HN), (float*)(ws + WS_SSP)};
      pg8::gemm_phase<EpiH, pg8::StaticOrder, true, true>(lds, g, S, E); }
    xcd_barrier(xbar);
    { pg8::Gemm g{(const bf16_t*)(ws + WS_HN), (const bf16_t*)(ws + WS_WUP), M, FF, D}; pg8::StaticOrder S; S.init(M, FF, G, bx);
      EpiUp E{(const float*)(ws + WS_SSP), (bf16_t*)(ws + WS_Z)};
      pg8::gemm_phase<EpiUp, pg8::StaticOrder, true, true>(lds, g, S, E); }
    xcd_barrier(xbar);
    if (G == 256 && bx >= 208) copy_beside(P, MISC, tid, 208u);
    else { pg8::Gemm g{(const bf16_t*)(ws + WS_Z), (const bf16_t*)(ws + WS_WDN), M, D, FF}; pg8::StaticOrder S; S.init(M, D, G == 256 ? 208 : G, bx);
      EpiDown E{P.out + O_Y};
      pg8::gemm_phase<EpiDown, pg8::StaticOrder, true, true>(lds, g, S, E);
      __syncthreads();
      if (tid == 0) __hip_atomic_fetch_add((unsigned*)P.ws + CW_DONE, 1u, __ATOMIC_RELAXED, __HIP_MEMORY_SCOPE_AGENT); }
    copy_rest(P, MISC, tid);
}
}

extern "C" void kernel_launch(void* const* d_in, const int* in_sizes, int n_in, void* d_out, int out_size, void* d_ws, size_t ws_size, hipStream_t stream) {
    using namespace mk;
    static int grid = 0;
    if (grid == 0) {
        if (n_in != 18 || (size_t)out_size != O_END || ws_size < WS_END) { fprintf(stderr, "kernel_launch: unexpected sizes: n_in %d out %d (want %zu) ws %zu (want %zu)\n", n_in, out_size, (size_t)O_END, ws_size, (size_t)WS_END); grid = -1; return; }
        int dev = 0, cus = 0, per_cu = 0;
        if (hipGetDevice(&dev) != hipSuccess || hipDeviceGetAttribute(&cus, hipDeviceAttributeMultiprocessorCount, dev) != hipSuccess) { grid = -1; return; }
        if (hipFuncSetAttribute((const void*)fwd_megakernel, hipFuncAttributeMaxDynamicSharedMemorySize, LDS_BYTES) != hipSuccess) { fprintf(stderr, "kernel_launch: hipFuncSetAttribute failed\n"); grid = -1; return; }
        if (hipOccupancyMaxActiveBlocksPerMultiprocessor(&per_cu, (const void*)fwd_megakernel, 512, LDS_BYTES) != hipSuccess || per_cu < 1) { fprintf(stderr, "kernel_launch: occupancy query gave %d\n", per_cu); per_cu = 1; }
        (void)hipGetLastError();
        grid = cus * 1;
    }
    if (grid < 0) return;
    if (hipMemsetAsync(d_ws, 0, 16384, stream) != hipSuccess) { fprintf(stderr, "kernel_launch: memset failed\n"); return; }
    Params p{};
    p.xp = (const float*)d_in[0]; p.xs = (const float*)d_in[1]; p.state_pool = (const float*)d_in[2]; p.cache0 = (const float*)d_in[3]; p.cache1 = (const float*)d_in[4]; p.cache2 = (const float*)d_in[5];
    p.ln1 = (const float*)d_in[6]; p.w_in = (const float*)d_in[7]; p.q_norm = (const float*)d_in[8]; p.k_norm = (const float*)d_in[9]; p.pool_lin = (const float*)d_in[10]; p.pool_scale = (const float*)d_in[11];
    p.w_pa = (const float*)d_in[12]; p.w_pb = (const float*)d_in[13]; p.w_o = (const float*)d_in[14]; p.ln2 = (const float*)d_in[15]; p.w_up = (const float*)d_in[16]; p.w_down = (const float*)d_in[17];
    p.out = (float*)d_out; p.ws = (unsigned char*)d_ws;
    void* args[] = {&p};
    hipError_t e = hipLaunchCooperativeKernel((const void*)fwd_megakernel, dim3(grid), dim3(512), args, LDS_BYTES, stream);
    if (e != hipSuccess) fprintf(stderr, "kernel_launch: cooperative launch failed: %s (grid %d)\n", hipGetErrorString(e), grid);
}
```
